# Optimizing an MI355X kernel written in HIP

```python
import jax, jax.numpy as jnp
from jax import lax
import numpy as np

D_MODEL = 2048
BATCH = 8
SEQ = 4096
DEPTH = 1

CHUNK = 64
RET_HEADS = 4
RET_DK = 256
RET_DV = 256
ML_HEADS = 4
ML_DK = 128
ML_DV = 256
CONV_W = 4
N_EXPERTS = 64
TOP_K = 8
N_GROUPS = 8
TOPK_GROUPS = 4
D_EXPERT = 512
D_SHARED = 512
ROUTED_SCALE = 2.5
EXPERT_BLOCK = 256
ROPE_BASE = 10000.0
LN_EPS = 1e-5
GN_EPS = 1e-6
DN_ALPHA = (2 * DEPTH) ** 0.25
DN_BETA = (8 * DEPTH) ** -0.25

RET_QK_W = RET_HEADS * RET_DK
RET_V_W = RET_HEADS * RET_DV
ML_QK_W = ML_HEADS * ML_DK
ML_V_W = ML_HEADS * ML_DV
MIX_W = RET_V_W + ML_V_W
IN_W = 2 * RET_QK_W + 2 * RET_V_W + 2 * ML_QK_W + 2 * ML_V_W + 2 * ML_HEADS

kernel_name = 'hybrid_retention_mlstm_moe_deepnorm_adaln'


def layer_norm(x, g, b):
    xf = x.astype(jnp.float32)
    mu = jnp.mean(xf, axis=-1, keepdims=True)
    var = jnp.mean(jnp.square(xf - mu), axis=-1, keepdims=True)
    return ((xf - mu) * lax.rsqrt(var + LN_EPS)).astype(x.dtype) * g + b


def head_norm(h, w):
    mu = jnp.mean(h, axis=-1, keepdims=True)
    var = jnp.mean(jnp.square(h - mu), axis=-1, keepdims=True)
    return (h - mu) * lax.rsqrt(var + GN_EPS) * w.astype(jnp.float32).reshape(h.shape[-2:])


def rotary(x):
    seq, d = x.shape[1], x.shape[-1]
    inv = ROPE_BASE ** (-jnp.arange(0, d, 2, dtype=jnp.float32) / d)
    ang = jnp.arange(seq, dtype=jnp.float32)[:, None] * inv
    cos = jnp.cos(ang)[None, :, None, :]
    sin = jnp.sin(ang)[None, :, None, :]
    x1, x2 = x[..., 0::2], x[..., 1::2]
    return jnp.stack([x1 * cos - x2 * sin, x1 * sin + x2 * cos], axis=-1).reshape(x.shape)


def to_chunks(x):
    B, S, H, d = x.shape
    return x.reshape(B, S // CHUNK, CHUNK, H, d).transpose(1, 0, 3, 2, 4)


def from_chunks(x):
    NC, B, H, L, d = x.shape
    return x.transpose(1, 0, 3, 2, 4).reshape(B, NC * L, H, d)


def gate_chunks(g):
    B, S, H = g.shape
    return g.reshape(B, S // CHUNK, CHUNK, H).transpose(1, 0, 3, 2)


def causal_dwconv(x, w, b):
    y = lax.conv_general_dilated(x, w[:, None, :], window_strides=(1,),
                                 padding=[(CONV_W - 1, 0)],
                                 dimension_numbers=('NWC', 'WIO', 'NWC'),
                                 feature_group_count=x.shape[-1])
    return y + b


def retention(q, k, v):
    B, S, H, _ = q.shape
    L = CHUNK
    log_g = jnp.log1p(-jnp.exp2(-5.0 - jnp.arange(H, dtype=jnp.float32)))
    idx = jnp.arange(L, dtype=jnp.float32)
    diff = idx[:, None] - idx[None, :]
    intra_decay = jnp.where(diff >= 0, jnp.exp(log_g[:, None, None] * jnp.maximum(diff, 0.0)), 0.0)
    q_decay = jnp.exp(log_g[:, None] * (idx + 1.0))[..., None]
    k_decay = jnp.exp(log_g[:, None] * (L - 1.0 - idx))[..., None]
    chunk_decay = jnp.exp(log_g * L)[:, None, None]
    qc, kc, vc = to_chunks(q), to_chunks(k * RET_DK ** -0.5), to_chunks(v)

    def step(state, blk):
        qb, kb, vb = blk
        s = jnp.einsum('bhid,bhjd->bhij', qb, kb) * intra_decay
        out = (jnp.einsum('bhij,bhjv->bhiv', s, vb)
               + jnp.einsum('bhid,bhdv->bhiv', qb * q_decay, state))
        state = chunk_decay * state + jnp.einsum('bhjd,bhjv->bhdv', kb * k_decay, vb)
        return state, out

    state0 = jnp.zeros((B, H, RET_DK, RET_DV), jnp.float32)
    _, out = lax.scan(step, state0, (qc, kc, vc))
    return from_chunks(out)


def mlstm(q, k, v, i_pre, f_pre):
    B, S, H, _ = q.shape
    L = CHUNK
    qc, kc, vc = to_chunks(q * ML_DK ** -0.5), to_chunks(k), to_chunks(v)
    ic, lfc = gate_chunks(i_pre), gate_chunks(jax.nn.log_sigmoid(f_pre))
    causal = jnp.tril(jnp.ones((L, L), dtype=bool))

    def step(carry, blk):
        C, n, m = carry
        qb, kb, vb, ib, lfb = blk
        b = jnp.cumsum(lfb, axis=-1)
        a = b + m[..., None]
        dlog = jnp.where(causal, b[..., :, None] - b[..., None, :] + ib[..., None, :], -jnp.inf)
        m_t = jnp.maximum(a, jnp.max(dlog, axis=-1))
        w_inter = jnp.exp(a - m_t)
        w_intra = jnp.exp(dlog - m_t[..., None])
        s = jnp.einsum('bhid,bhjd->bhij', qb, kb) * w_intra
        num = (jnp.einsum('bhij,bhjv->bhiv', s, vb)
               + w_inter[..., None] * jnp.einsum('bhid,bhdv->bhiv', qb, C))
        den = jnp.sum(s, axis=-1) + w_inter * jnp.einsum('bhid,bhd->bhi', qb, n)
        h = num / jnp.maximum(jnp.abs(den), jnp.exp(-m_t))[..., None]
        m_new = m_t[..., -1]
        g_state = jnp.exp(b[..., -1] + m - m_new)
        g_k = jnp.exp(b[..., -1:] - b + ib - m_new[..., None])
        kw = kb * g_k[..., None]
        C = g_state[..., None, None] * C + jnp.einsum('bhjd,bhjv->bhdv', kw, vb)
        n = g_state[..., None] * n + jnp.sum(kw, axis=2)
        return (C, n, m_new), h

    carry0 = (jnp.zeros((B, H, ML_DK, ML_DV), jnp.float32),
              jnp.zeros((B, H, ML_DK), jnp.float32),
              jnp.zeros((B, H), jnp.float32))
    _, out = lax.scan(step, carry0, (qc, kc, vc, ic, lfc))
    return from_chunks(out)


def token_mix(u, w_in, b_gates, conv_w, conv_b, ret_norm_w, ml_norm_w, w_out):
    B, S, _ = u.shape
    f32 = jnp.float32
    proj = jnp.einsum('bsd,de->bse', u, w_in).astype(f32)
    sizes = [RET_QK_W, RET_QK_W, RET_V_W, RET_V_W, 2 * ML_QK_W, ML_V_W, ML_V_W, 2 * ML_HEADS]
    cuts = np.cumsum(sizes)[:-1].tolist()
    rq, rk, rv, rg, mqk, mv, mo, gates = jnp.split(proj, cuts, axis=-1)
    rq = rotary(rq.reshape(B, S, RET_HEADS, RET_DK))
    rk = rotary(rk.reshape(B, S, RET_HEADS, RET_DK))
    r = retention(rq, rk, rv.reshape(B, S, RET_HEADS, RET_DV))
    r = head_norm(r, ret_norm_w).reshape(B, S, RET_V_W) * jax.nn.silu(rg)
    mqk = jax.nn.silu(causal_dwconv(mqk, conv_w.astype(f32), conv_b.astype(f32)))
    mq, mk = jnp.split(mqk, 2, axis=-1)
    gates = gates + b_gates.astype(f32)
    i_pre, f_pre = gates[..., :ML_HEADS], gates[..., ML_HEADS:]
    h = mlstm(mq.reshape(B, S, ML_HEADS, ML_DK), mk.reshape(B, S, ML_HEADS, ML_DK),
              mv.reshape(B, S, ML_HEADS, ML_DV), i_pre, f_pre)
    h = head_norm(h, ml_norm_w).reshape(B, S, ML_V_W) * jax.nn.sigmoid(mo)
    mixed = jnp.concatenate([r, h], axis=-1).astype(u.dtype)
    return jnp.einsum('bsm,md->bsd', mixed, w_out)


def route(t, w_router, e_bias):
    T = t.shape[0]
    scores = jax.nn.sigmoid(jnp.einsum('td,de->te', t, w_router).astype(jnp.float32))
    biased = scores + e_bias.astype(jnp.float32)
    per_group = N_EXPERTS // N_GROUPS
    grp_score = jnp.sum(lax.top_k(biased.reshape(T, N_GROUPS, per_group), 2)[0], axis=-1)
    _, gidx = lax.top_k(grp_score, TOPK_GROUPS)
    gmask = jnp.sum(jax.nn.one_hot(gidx, N_GROUPS, dtype=jnp.float32), axis=-2) > 0
    masked = jnp.where(jnp.repeat(gmask, per_group, axis=-1), biased, -jnp.inf)
    _, eidx = lax.top_k(masked, TOP_K)
    w = jnp.take_along_axis(scores, eidx, axis=-1)
    w = w / jnp.sum(w, axis=-1, keepdims=True) * ROUTED_SCALE
    return eidx, w


def routed_experts(t, eidx, wts, w_gate, w_up, w_down):
    T, Dm = t.shape
    A = T * TOP_K
    G = EXPERT_BLOCK
    e_flat = eidx.reshape(A)
    tok_flat = jnp.repeat(jnp.arange(T, dtype=jnp.int32), TOP_K)
    order = jnp.argsort(e_flat)
    e_s, tok_s, w_s = e_flat[order], tok_flat[order], wts.reshape(A)[order]
    counts = jnp.bincount(e_flat, length=N_EXPERTS)
    start = jnp.cumsum(counts) - counts
    padded = (counts + G - 1) // G * G
    pad_end = jnp.cumsum(padded)
    pad_start = pad_end - padded
    dest = pad_start[e_s] + jnp.arange(A, dtype=pad_start.dtype) - start[e_s]
    n_blocks = -(-(A + N_EXPERTS * (G - 1)) // G)
    buf_tok = jnp.zeros((n_blocks * G,), jnp.int32).at[dest].set(tok_s)
    buf_w = jnp.zeros((n_blocks * G,), t.dtype).at[dest].set(w_s.astype(t.dtype))
    block_e = jnp.minimum(jnp.searchsorted(pad_end, jnp.arange(n_blocks) * G, side='right'),
                          N_EXPERTS - 1)

    def body(acc, blk):
        tok_b, w_b, e_b = blk
        xb = t[tok_b]
        hb = jax.nn.silu(xb @ w_gate[e_b]) * (xb @ w_up[e_b])
        return acc.at[tok_b].add((hb @ w_down[e_b]) * w_b[:, None]), None

    acc, _ = lax.scan(body, jnp.zeros_like(t),
                      (buf_tok.reshape(n_blocks, G), buf_w.reshape(n_blocks, G), block_e))
    return acc


def channel_mix(u, w_router, e_bias, w_gate, w_up, w_down, ws_gate, ws_up, ws_down):
    B, S, Dm = u.shape
    t = u.reshape(B * S, Dm)
    eidx, wts = route(t, w_router, e_bias)
    routed = routed_experts(t, eidx, wts, w_gate, w_up, w_down)
    shared = (jax.nn.silu(t @ ws_gate) * (t @ ws_up)) @ ws_down
    return (routed + shared).reshape(B, S, Dm)


def setup_inputs(seed: int = 0) -> dict:
    key = jax.random.key(seed)
    ks = jax.random.split(key, 24)
    nrm = jax.random.normal
    f32 = jnp.float32
    Dm, E, F, Fs = D_MODEL, N_EXPERTS, D_EXPERT, D_SHARED
    f_bias = jnp.linspace(3.0, 6.0, ML_HEADS, dtype=f32)
    b_gates = jnp.concatenate([0.1 * nrm(ks[4], (DEPTH, ML_HEADS), f32),
                               f_bias + 0.1 * nrm(ks[5], (DEPTH, ML_HEADS), f32)], axis=-1)
    return {
        'x': nrm(ks[0], (BATCH, SEQ, Dm), f32),
        'c': nrm(ks[1], (BATCH, Dm), f32),
        'w_ada': nrm(ks[2], (DEPTH, Dm, 6 * Dm), f32) * Dm ** -0.5,
        'b_ada': 0.02 * nrm(ks[3], (DEPTH, 6 * Dm), f32),
        'w_in': nrm(ks[6], (DEPTH, Dm, IN_W), f32) * Dm ** -0.5,
        'b_gates': b_gates,
        'conv_w': nrm(ks[7], (DEPTH, CONV_W, 2 * ML_QK_W), f32) * CONV_W ** -0.5,
        'conv_b': 0.02 * nrm(ks[8], (DEPTH, 2 * ML_QK_W), f32),
        'ret_norm_w': 1.0 + 0.02 * nrm(ks[9], (DEPTH, RET_V_W), f32),
        'ml_norm_w': 1.0 + 0.02 * nrm(ks[10], (DEPTH, ML_V_W), f32),
        'w_out': nrm(ks[11], (DEPTH, MIX_W, Dm), f32) * MIX_W ** -0.5 * DN_BETA,
        'ln1_g': 1.0 + 0.02 * nrm(ks[12], (DEPTH, Dm), f32),
        'ln1_b': 0.02 * nrm(ks[13], (DEPTH, Dm), f32),
        'w_router': nrm(ks[14], (DEPTH, Dm, E), f32) * Dm ** -0.5,
        'e_bias': 0.01 * nrm(ks[15], (DEPTH, E), f32),
        'w_gate': nrm(ks[16], (DEPTH, E, Dm, F), f32) * Dm ** -0.5,
        'w_up': nrm(ks[17], (DEPTH, E, Dm, F), f32) * Dm ** -0.5,
        'w_down': nrm(ks[18], (DEPTH, E, F, Dm), f32) * F ** -0.5 * DN_BETA,
        'ws_gate': nrm(ks[19], (DEPTH, Dm, Fs), f32) * Dm ** -0.5,
        'ws_up': nrm(ks[20], (DEPTH, Dm, Fs), f32) * Dm ** -0.5,
        'ws_down': nrm(ks[21], (DEPTH, Fs, Dm), f32) * Fs ** -0.5 * DN_BETA,
        'ln2_g': 1.0 + 0.02 * nrm(ks[22], (DEPTH, Dm), f32),
        'ln2_b': 0.02 * nrm(ks[23], (DEPTH, Dm), f32),
    }


def reference(x, c, w_ada, b_ada, w_in, b_gates, conv_w, conv_b, ret_norm_w, ml_norm_w, w_out,
              ln1_g, ln1_b, w_router, e_bias, w_gate, w_up, w_down, ws_gate, ws_up, ws_down,
              ln2_g, ln2_b):
    for l in range(DEPTH):
        mod = jnp.einsum('bd,de->be', jax.nn.silu(c), w_ada[l]) + b_ada[l]
        sh1, sc1, g1, sh2, sc2, g2 = jnp.split(mod[:, None, :], 6, axis=-1)
        u = x * (1 + sc1) + sh1
        mix = token_mix(u, w_in[l], b_gates[l], conv_w[l], conv_b[l], ret_norm_w[l],
                        ml_norm_w[l], w_out[l])
        x = layer_norm(DN_ALPHA * x + g1 * mix, ln1_g[l], ln1_b[l])
        u = x * (1 + sc2) + sh2
        y = channel_mix(u, w_router[l], e_bias[l], w_gate[l], w_up[l], w_down[l],
                        ws_gate[l], ws_up[l], ws_down[l])
        x = layer_norm(DN_ALPHA * x + g2 * y, ln2_g[l], ln2_b[l])
    return x
```

```cpp
#include <hip/hip_runtime.h>
#include <cstdio>
#include <cstdint>

#define LAS __attribute__((address_space(3)))
typedef unsigned short bf16_t;
typedef short bf16x8 __attribute__((ext_vector_type(8)));
typedef float f32x4 __attribute__((ext_vector_type(4)));
typedef float f32x2 __attribute__((ext_vector_type(2)));
typedef unsigned u32x4 __attribute__((ext_vector_type(4)));
typedef unsigned u32x2 __attribute__((ext_vector_type(2)));
typedef int i32x4 __attribute__((ext_vector_type(4)));
typedef int i32x8 __attribute__((ext_vector_type(8)));

constexpr int DM = 2048, NBATCH = 8, SEQ = 4096, T = NBATCH * SEQ;
constexpr int INW = 7176, INWM = 7168;
constexpr int NE = 64, FE = 512;
constexpr int MODW = 6 * DM;
constexpr float DN_ALPHA = 1.189207115002721f;
constexpr float LN_EPS = 1e-5f, GN_EPS = 1e-6f;
constexpr int NTHREADS = 512, NWAVES = 8;
constexpr int PC_RQ = 0, PC_RK = 1024, PC_RV = 2048, PC_RG = 3072, PC_MQK = 4096, PC_MV = 5120, PC_MO = 6144;

constexpr size_t MiB = 1u << 20;
constexpr size_t WS_CTL = 0, CTL_BYTES = 1 * MiB;
constexpr size_t WS_MOD = 1 * MiB;
constexpr size_t WS_GATEW = 1 * MiB + 512 * 1024;
constexpr size_t WS_GATES = 2 * MiB;
constexpr size_t WS_WRHI = 3 * MiB, WS_WRLO = 3 * MiB + 256 * 1024;
constexpr size_t WS_POS = 4 * MiB;
constexpr size_t WS_WTS = 5 * MiB;
constexpr size_t WS_BINTOK = 8 * MiB;
constexpr size_t WS_WIN = 24 * MiB;
constexpr size_t WS_WOUT = 52 * MiB;
constexpr size_t WS_WD = 60 * MiB;
constexpr size_t WS_WGU = 190 * MiB;
constexpr size_t WS_RA = 450 * MiB;
constexpr size_t WS_U1B = WS_RA;
constexpr size_t WS_CONV = 320 * MiB;
constexpr size_t WS_RC = 578 * MiB;
constexpr size_t WS_RB = 706 * MiB;
constexpr size_t WS_U2 = WS_RB, WS_H = WS_RB + 128 * MiB;
constexpr size_t WS_O = 190 * MiB;
constexpr size_t WS_X1B = 990 * MiB;
constexpr size_t WS_DUMMY = 1118 * MiB;
constexpr size_t WS_END = 1154 * MiB;
static_assert(WS_O + (size_t)311296 * 1024 * 2 <= WS_H, "o overlay");
static_assert(WS_H + (size_t)311296 * 1024 <= WS_END, "h");
constexpr int CW_BAR = 4096, CW_CNT = 8192, CW_QUEUE = 8192 + 256;

constexpr int RING_BYTES = 131072;
constexpr int TAB_OFF = 131072;
constexpr int LDS_BYTES = 147456;
constexpr int BARW_OFF = LDS_BYTES - 64;

struct Params {
    const float *x, *c, *w_ada, *b_ada, *w_in, *b_gates, *conv_w, *conv_b, *ret_norm_w, *ml_norm_w, *w_out, *ln1_g, *ln1_b,
                *w_router, *e_bias, *w_gate, *w_up, *w_down, *ws_gate, *ws_up, *ws_down, *ln2_g, *ln2_b;
    float* out; unsigned char* ws; int ph_lo, ph_hi;
};

__device__ __forceinline__ unsigned cvt_pk_bf16(float lo, float hi) { unsigned r; asm("v_cvt_pk_bf16_f32 %0, %1, %2" : "=v"(r) : "v"(lo), "v"(hi)); return r; }
__device__ __forceinline__ float bf_lo(unsigned w) { return __uint_as_float(w << 16); }
__device__ __forceinline__ float bf_hi(unsigned w) { return __uint_as_float(w & 0xffff0000u); }
__device__ __forceinline__ float bf2f(bf16_t b) { return __uint_as_float(((unsigned)b) << 16); }
#define DPPF(v, ctrl) __builtin_bit_cast(float, __builtin_amdgcn_update_dpp(0, __builtin_bit_cast(int, (v)), (ctrl), 0xF, 0xF, true))
__device__ __forceinline__ float row_sum16(float v) {
    v += DPPF(v, 0xB1);
    v += DPPF(v, 0x4E);
    v += DPPF(v, 0x141);
    v += DPPF(v, 0x140);
    return v;
}
__device__ __forceinline__ float rl(float v, int l) { return __builtin_bit_cast(float, __builtin_amdgcn_readlane(__builtin_bit_cast(int, v), l)); }
__device__ __forceinline__ float wave_sum(float v) { const float r = row_sum16(v); return (rl(r, 0) + rl(r, 16)) + (rl(r, 32) + rl(r, 48)); }
__device__ __forceinline__ float half_sum(float v) {
    const float r = row_sum16(v); const float lo = rl(r, 0) + rl(r, 16), hi = rl(r, 32) + rl(r, 48);
    return (threadIdx.x & 32) ? hi : lo;
}
__device__ __forceinline__ float fsilu(float x) { return x * __builtin_amdgcn_rcpf(1.0f + __builtin_amdgcn_exp2f(-1.4426950408889634f * x)); }
__device__ __forceinline__ float fsigmoid(float x) { return __builtin_amdgcn_rcpf(1.0f + __builtin_amdgcn_exp2f(-1.4426950408889634f * x)); }
#define LDS_WAIT() asm volatile("s_waitcnt lgkmcnt(0)" ::: "memory")

#define XB_TMO      128
#define XB_XCNT(j)  (256  + 64 * (j))
#define XB_XSUB(j)  (1280 + 64 * (j))
#define XB_XGEN(j)  (2304 + 64 * (j))
#define XB_TOP      3328
#define XB_TOPGEN   3392
#define XCD_BAR_WORDS 3456
#define XB_SPIN_CAP (1u << 18)
__device__ __forceinline__ unsigned xb_ld(unsigned* p)              { return __hip_atomic_load(p, __ATOMIC_RELAXED, __HIP_MEMORY_SCOPE_AGENT); }
__device__ __forceinline__ unsigned xb_add(unsigned* p, unsigned v) { return __hip_atomic_fetch_add(p, v, __ATOMIC_RELAXED, __HIP_MEMORY_SCOPE_AGENT); }
__device__ __forceinline__ unsigned xb_xcc_id() { return (unsigned)__builtin_amdgcn_s_getreg((3 << 11) | 20) & 0xFu; }
#define XB_SPIN(cond, bar) do { unsigned _sp = 0; while (cond) { __builtin_amdgcn_s_sleep(1); \
    if ((++_sp & 255u) == 0u) { if (xb_ld(&(bar)[XB_TMO])) break; if (_sp > XB_SPIN_CAP) { atomicAdd(&(bar)[XB_TMO], 1u); break; } } } } while (0)
struct XcdBarrier { unsigned* bar; unsigned x; volatile LAS unsigned* st; };
__device__ __forceinline__ XcdBarrier xcd_barrier_post(unsigned* bar, volatile LAS unsigned* st) {
    XcdBarrier b; b.bar = bar; b.x = xb_xcc_id(); b.st = st;
    if (threadIdx.x == 0) (void)xb_add(&bar[XB_XCNT(b.x)], 1u);
    return b;
}
__device__ __forceinline__ void xcd_barrier_complete(unsigned* bar, unsigned x, unsigned& nloc, unsigned& nx) {
    const unsigned G = gridDim.x * gridDim.y * gridDim.z;
    unsigned sum, cnt, mine, sp = 0u;
    for (;;) {
        sum = 0u; cnt = 0u; mine = 0u;
#pragma unroll
        for (unsigned j = 0; j < 16; ++j) { const unsigned c = xb_ld(&bar[XB_XCNT(j)]); sum += c; cnt += (c > 0u) ? 1u : 0u; mine = (j == x) ? c : mine; }
        if (sum == G) break;
        __builtin_amdgcn_s_sleep(1);
        if ((++sp & 255u) == 0u) { if (xb_ld(&bar[XB_TMO])) break; if (sp > XB_SPIN_CAP) { atomicAdd(&bar[XB_TMO], 1u); break; } }
    }
    nloc = mine > 0u ? mine : 1u; nx = cnt > 0u ? cnt : 1u;
}
__device__ __forceinline__ void xcd_barrier(const XcdBarrier& b) {
    asm volatile("s_waitcnt vmcnt(0)" ::: "memory");
    __syncthreads();
    if (threadIdx.x == 0) {
        unsigned* bar = b.bar;
        __builtin_amdgcn_s_waitcnt(0);
        unsigned nloc = b.st[0], nx = b.st[1];
        if (nloc == 0u) { xcd_barrier_complete(bar, b.x, nloc, nx); b.st[0] = nloc; b.st[1] = nx; }
        const unsigned old = xb_add(&bar[XB_XSUB(b.x)], 1u);
        const unsigned gen = old / nloc;
        if (old + 1u == (gen + 1u) * nloc) {
            __builtin_amdgcn_fence(__ATOMIC_RELEASE, "agent");
            asm volatile("s_waitcnt vmcnt(0)" ::: "memory");
            const unsigned og = xb_add(&bar[XB_TOP], 1u);
            const unsigned tg = og / nx;
            if (og + 1u == (tg + 1u) * nx) xb_add(&bar[XB_TOPGEN], 1u);
            else XB_SPIN(xb_ld(&bar[XB_TOPGEN]) == tg, bar);
            __builtin_amdgcn_fence(__ATOMIC_ACQUIRE, "agent");
            xb_add(&bar[XB_XGEN(b.x)], 1u);
            asm volatile("s_waitcnt vmcnt(0)" ::: "memory");
        } else {
            XB_SPIN(xb_ld(&bar[XB_XGEN(b.x)]) == gen, bar);
            __builtin_amdgcn_fence(__ATOMIC_ACQUIRE, "agent");
            asm volatile("s_waitcnt vmcnt(0)" ::: "memory");
        }
    }
    __syncthreads();
}

namespace pg8 {
constexpr int BM = 256, BK = 64, HALF = 128, HTB = HALF * BK * 2, STAGE_BYTES = 8 * HTB, NXCD = 8, WGM = 8;
__host__ __device__ __forceinline__ int lds_byte(int r, int c) { const int st = (r >> 4) * 2 + (c >> 5), rr = r & 15, cc = c & 31, ob = rr * 64 + cc * 2; return st * 1024 + (ob ^ (((ob >> 9) & 1) << 5)); }
__host__ __device__ __forceinline__ void stage_rc(int b, int& R, int& C) { const int st = b / 1024, sb = b % 1024, swz = sb ^ (((sb >> 9) & 1) << 5); R = (st >> 1) * 16 + swz / 64; C = (st & 1) * 32 + (swz % 64) / 2; }
__host__ __device__ __forceinline__ int perm32(int rho) { const int n = rho >> 4, i = rho & 15, fq = i >> 2; return 16 * (fq & 1) + 8 * (fq >> 1) + 4 * n + (i & 3); }

struct Unit { int pm, pn; const char* B; int e, r0, cnt, crow0; };

__device__ __forceinline__ bool order_next(int i, int G, int c, int nM, int nN, int& pm, int& pn) {
    const int nwg = nM * nN; const long L = (long)i * G + c; if (L >= nwg) return false;
    int wgid = (int)L; { const int q = nwg / NXCD, r = nwg % NXCD, xcd = wgid % NXCD, off = wgid / NXCD; wgid = (xcd < r ? xcd * (q + 1) : r * (q + 1) + (xcd - r) * q) + off; }
    const int nig = WGM * nN, gid = wgid / nig, fm = gid * WGM, gsz = (nM - fm) < WGM ? (nM - fm) : WGM;
    pm = fm + ((wgid % nig) % gsz); pn = (wgid % nig) / gsz; return true;
}

struct SchedDense {
    int nM, nN, G, c; const char* Bt; int KB; int pn_off;
    __device__ __forceinline__ bool next(int i, Unit& u) const {
        if (!order_next(i, G, c, nM, nN, u.pm, u.pn)) return false;
        u.pn += pn_off; u.B = Bt + (size_t)u.pn * 256 * KB; u.e = 0; u.r0 = 0; u.cnt = 0; u.crow0 = 0; return true;
    }
    __device__ __forceinline__ void a_rows(const Unit& u, const int (&Rp)[2], int (&ix)[2][2]) const {
#pragma unroll
        for (int h = 0; h < 2; ++h)
#pragma unroll
            for (int i = 0; i < 2; ++i) ix[h][i] = u.pm * 256 + h * 128 + Rp[i];
    }
};
struct SchedMoE {
    LAS const int* tstart; LAS const int* cstart; LAS const int* cnt; LAS const int* tile_e;
    int NRT, nN, pn_off, G, c; const char* W; size_t wstride; int KB; int gather; const int* bin_tok;
    __device__ __forceinline__ bool next(int i, Unit& u) const {
        if (!order_next(i, G, c, NRT, nN, u.pm, u.pn)) return false;
        const int e = tile_e[u.pm]; const int j = u.pm - tstart[e];
        u.e = e; u.r0 = 256 * j; u.cnt = cnt[e]; u.crow0 = cstart[e] + 256 * j;
        u.B = W + (size_t)e * wstride + (size_t)(u.pn + pn_off) * 256 * KB; return true;
    }
    __device__ __forceinline__ void a_rows(const Unit& u, const int (&Rp)[2], int (&ix)[2][2]) const {
#pragma unroll
        for (int h = 0; h < 2; ++h)
#pragma unroll
            for (int i = 0; i < 2; ++i) {
                if (gather) { const int slot = u.r0 + h * 128 + Rp[i]; int tok = slot;
                    if (u.e < NE) tok = (slot < u.cnt) ? bin_tok[u.e * 32768 + slot] : 0;
                    ix[h][i] = tok; }
                else ix[h][i] = u.pm * 256 + h * 128 + Rp[i];
            }
    }
};

struct EpiPlain { static constexpr int PERM = 2; static constexpr int NSTORE = 16; bf16_t* O; int ldc; float sc;
    __device__ __forceinline__ void operator()(const f32x4 (&acc)[2][2][4][2], const Unit& u, int wr, int wc, int fr, int fq) const {
        const int row0 = u.pm * BM + wr * 64 + fr, col0 = u.pn * BM + wc * 64 + 16 * fq;
#pragma unroll
        for (int ai = 0; ai < 2; ++ai)
#pragma unroll
            for (int m = 0; m < 4; ++m) { bf16_t* rowp = O + (size_t)(row0 + ai * HALF + m * 16) * ldc + col0;
#pragma unroll
                for (int bj = 0; bj < 2; ++bj) { const f32x4 v0 = acc[ai][bj][m][0] * sc, v1 = acc[ai][bj][m][1] * sc;
                    u32x4 w; w.x = cvt_pk_bf16(v0[0], v0[1]); w.y = cvt_pk_bf16(v0[2], v0[3]); w.z = cvt_pk_bf16(v1[0], v1[1]); w.w = cvt_pk_bf16(v1[2], v1[3]);
                    *(u32x4*)(rowp + bj * 8) = w; } }
    }
};
struct EpiPlain8 { static constexpr int PERM = 2; static constexpr int NSTORE = 8; unsigned char* O; int ldc; float sc;
    __device__ __forceinline__ void operator()(const f32x4 (&acc)[2][2][4][2], const Unit& u, int wr, int wc, int fr, int fq) const {
        const int row0 = u.pm * BM + wr * 64 + fr, col0 = u.pn * BM + wc * 64 + 16 * fq;
#pragma unroll
        for (int ai = 0; ai < 2; ++ai)
#pragma unroll
            for (int m = 0; m < 4; ++m) { unsigned char* rowp = O + (size_t)(row0 + ai * HALF + m * 16) * ldc + col0; int d[4] = {0, 0, 0, 0};
#pragma unroll
                for (int bj = 0; bj < 2; ++bj) { const f32x4 v0 = acc[ai][bj][m][0] * sc, v1 = acc[ai][bj][m][1] * sc;
                    d[2 * bj] = __builtin_amdgcn_cvt_pk_fp8_f32(v0[0], v0[1], d[2 * bj], false); d[2 * bj] = __builtin_amdgcn_cvt_pk_fp8_f32(v0[2], v0[3], d[2 * bj], true);
                    d[2 * bj + 1] = __builtin_amdgcn_cvt_pk_fp8_f32(v1[0], v1[1], d[2 * bj + 1], false); d[2 * bj + 1] = __builtin_amdgcn_cvt_pk_fp8_f32(v1[2], v1[3], d[2 * bj + 1], true); }
                *(u32x4*)rowp = (u32x4){(unsigned)d[0], (unsigned)d[1], (unsigned)d[2], (unsigned)d[3]}; }
    }
};
struct EpiProj { static constexpr int PERM = 2; static constexpr int NSTORE = 16; bf16_t* O;
    __device__ __forceinline__ void operator()(const f32x4 (&acc)[2][2][4][2], const Unit& u, int wr, int wc, int fr, int fq) const {
        const int row0 = u.pm * BM + wr * 64 + fr, col0 = u.pn * BM + wc * 64 + 16 * fq;
        const bool rot = u.pn < 8; const float ks = (u.pn >= 4 && u.pn < 8) ? 0.0625f : 1.0f;
        float inv[2][2][2];
#pragma unroll
        for (int bj = 0; bj < 2; ++bj)
#pragma unroll
            for (int n = 0; n < 2; ++n)
#pragma unroll
                for (int q = 0; q < 2; ++q) { const int d = 64 * wc + 16 * fq + 8 * bj + 4 * n + 2 * q; inv[bj][n][q] = __builtin_amdgcn_exp2f(-(float)(d >> 1) * 0.10381025296523008f) * 0.15915494309189535f; }
#pragma unroll
        for (int ai = 0; ai < 2; ++ai)
#pragma unroll
            for (int m = 0; m < 4; ++m) { const int row = row0 + ai * HALF + m * 16; const float fs = (float)(row & (SEQ - 1)); bf16_t* rowp = O + (size_t)row * INWM + col0;
#pragma unroll
                for (int bj = 0; bj < 2; ++bj) { f32x4 v[2] = {acc[ai][bj][m][0], acc[ai][bj][m][1]};
                    if (rot) {
#pragma unroll
                        for (int n = 0; n < 2; ++n)
#pragma unroll
                            for (int q = 0; q < 2; ++q) { float t = fs * inv[bj][n][q]; t = t - floorf(t);
                                const float sn = __builtin_amdgcn_sinf(t), cs = __builtin_amdgcn_cosf(t); const float a = v[n][2 * q], b = v[n][2 * q + 1];
                                v[n][2 * q] = (a * cs - b * sn) * ks; v[n][2 * q + 1] = (a * sn + b * cs) * ks; } }
                    u32x4 w; w.x = cvt_pk_bf16(v[0][0], v[0][1]); w.y = cvt_pk_bf16(v[0][2], v[0][3]); w.z = cvt_pk_bf16(v[1][0], v[1][1]); w.w = cvt_pk_bf16(v[1][2], v[1][3]);
                    *(u32x4*)(rowp + bj * 8) = w; } }
    }
};
struct EpiSwiGLU8 { static constexpr int PERM = 1; static constexpr int NSTORE = 4; unsigned char* H;
    __device__ __forceinline__ void operator()(const f32x4 (&acc)[2][2][4][2], const Unit& u, int wr, int wc, int fr, int fq) const {
        const int row0 = u.pm * BM + wr * 64 + fr + ((fq >> 1) ? 16 : 0), col0 = u.pn * HALF + wc * 32 + 16 * (fq & 1);
#pragma unroll
        for (int ai = 0; ai < 2; ++ai)
#pragma unroll
            for (int mp = 0; mp < 2; ++mp) {
                unsigned d[2][2];
#pragma unroll
                for (int q = 0; q < 2; ++q) { const int m = 2 * mp + q; float hv[8];
#pragma unroll
                    for (int n = 0; n < 2; ++n)
#pragma unroll
                        for (int j = 0; j < 4; ++j) hv[4 * n + j] = fsilu(acc[ai][0][m][n][j] * 0.015625f) * (acc[ai][1][m][n][j] * 0.015625f);
                    int d0 = 0, d1 = 0;
                    d0 = __builtin_amdgcn_cvt_pk_fp8_f32(hv[0], hv[1], d0, false); d0 = __builtin_amdgcn_cvt_pk_fp8_f32(hv[2], hv[3], d0, true);
                    d1 = __builtin_amdgcn_cvt_pk_fp8_f32(hv[4], hv[5], d1, false); d1 = __builtin_amdgcn_cvt_pk_fp8_f32(hv[6], hv[7], d1, true);
                    d[q][0] = (unsigned)d0; d[q][1] = (unsigned)d1; }
                const auto s0 = __builtin_amdgcn_permlane32_swap(d[0][0], d[1][0], false, false);
                const auto s1 = __builtin_amdgcn_permlane32_swap(d[0][1], d[1][1], false, false);
                *(u32x4*)(H + (size_t)(row0 + ai * HALF + mp * 32) * FE + col0) = (u32x4){s0[0], s1[0], s0[1], s1[1]};
            }
    }
};

#define CFG_P2 true, true
#define CFG_P6 true, true
#define CFG_P8 true, true
#define CFG_P9 true, true
template <bool FP8, bool SP2, bool ALIGN_EPI, class Epi, class Sched>
__device__ __forceinline__ void gemm_phase(LAS unsigned char* lds, const char* Abase, const int KB, const Sched& S, const Epi& E, void* dummy) {
    const int tid = threadIdx.x, wid = __builtin_amdgcn_readfirstlane(tid >> 6), lane = tid & 63, wr = wid >> 2, wc = wid & 3, fr = lane & 15, fq = lane >> 4;
    const int nt = KB / (BK * 2);
    int Rp[2]; unsigned cb[2], voffB[2][2];
#pragma unroll
    for (int i = 0; i < 2; ++i) { int R, C; stage_rc(tid * 16 + i * 8192, R, C); Rp[i] = R; cb[i] = (unsigned)C * 2u;
#pragma unroll
        for (int h = 0; h < 2; ++h) { const int Rb = (Epi::PERM == 2) ? (64 * (R >> 5) + 16 * ((R & 15) >> 2) + 8 * h + 4 * ((R >> 4) & 1) + (R & 3)) : (128 * h + (R & ~31) + perm32(R & 31));
            voffB[h][i] = (unsigned)(Rb * KB + C * 2); } }
    const unsigned rowb = (unsigned)KB;
    const size_t kstep = (size_t)(BK * 2);
    const size_t hstep = (size_t)HALF * KB;
    const unsigned ldsw = (unsigned)wid * 1024u;
    const int aoff = FP8 ? lds_byte(wr * 64 + fr, 16 * fq) : lds_byte(wr * 64 + fr, fq * 8), boff = FP8 ? lds_byte(wc * 32 + fr, 16 * fq) : lds_byte(wc * 32 + fr, fq * 8);
    constexpr int KOFF = FP8 ? 16 : 1024;
#define PG8_SA(b, h) (((b) * 2 + (h)) * HTB)
#define PG8_SB(b, h) ((4 + (b) * 2 + (h)) * HTB)
#define PG8_STAGEA(bufoff, kb, av) do { _Pragma("unroll") for (int _i = 0; _i < 2; ++_i) \
        __builtin_amdgcn_global_load_lds((const unsigned*)(Abase + (kb) + (av)[_i]), (LAS unsigned*)(lds + (bufoff) + ldsw + _i * 8192), 16, 0, 0); } while (0)
#define PG8_STAGEB(bufoff, gbase, h) do { _Pragma("unroll") for (int _i = 0; _i < 2; ++_i) \
        __builtin_amdgcn_global_load_lds((const unsigned*)((const char*)(gbase) + voffB[h][_i]), (LAS unsigned*)(lds + (bufoff) + ldsw + _i * 8192), 16, 0, 0); } while (0)
#define PG8_LDA(dst, b, h) do { _Pragma("unroll") for (int m = 0; m < 4; ++m) _Pragma("unroll") for (int k = 0; k < 2; ++k) dst[m][k] = *(const LAS bf16x8*)(lds + PG8_SA(b, h) + aoff + m * 2048 + k * KOFF); } while (0)
#define PG8_LDB(dst, b, h) do { _Pragma("unroll") for (int n = 0; n < 2; ++n) _Pragma("unroll") for (int k = 0; k < 2; ++k) dst[n][k] = *(const LAS bf16x8*)(lds + PG8_SB(b, h) + boff + n * 2048 + k * KOFF); } while (0)
#define PG8_CAT8(x) __builtin_shufflevector(__builtin_bit_cast(i32x4, (x)[0]), __builtin_bit_cast(i32x4, (x)[1]), 0, 1, 2, 3, 4, 5, 6, 7)
#define PG8_MMA(ai, bj, At, Bt) do { __builtin_amdgcn_s_setprio(1); _Pragma("unroll") for (int m = 0; m < 4; ++m) _Pragma("unroll") for (int n = 0; n < 2; ++n) { \
        if constexpr (FP8) { const i32x8 a8_ = PG8_CAT8(Bt[n]), b8_ = PG8_CAT8(At[m]); asm volatile("v_mfma_f32_16x16x128_f8f6f4 %0, %1, %2, %0" : "+v"(acc[ai][bj][m][n]) : "v"(a8_), "v"(b8_)); } \
        else { _Pragma("unroll") for (int k = 0; k < 2; ++k) acc[ai][bj][m][n] = __builtin_amdgcn_mfma_f32_16x16x32_bf16(Bt[n][k], At[m][k], acc[ai][bj][m][n], 0, 0, 0); } } \
        __builtin_amdgcn_s_setprio(0); } while (0)
#define PG8_MMA0(ai, bj, At, Bt) do { __builtin_amdgcn_s_setprio(1); _Pragma("unroll") for (int m = 0; m < 4; ++m) _Pragma("unroll") for (int n = 0; n < 2; ++n) { \
        const i32x8 a8_ = PG8_CAT8(Bt[n]), b8_ = PG8_CAT8(At[m]); asm volatile("v_mfma_f32_16x16x128_f8f6f4 %0, %1, %2, 0" : "=&v"(acc[ai][bj][m][n]) : "v"(a8_), "v"(b8_)); } \
        __builtin_amdgcn_s_setprio(0); } while (0)
#define PG8_WAIT_V(n) asm volatile("s_waitcnt vmcnt(" #n ")" ::: "memory")
#define PG8_WAIT_L(n) asm volatile("s_waitcnt lgkmcnt(" #n ")" ::: "memory")
#define PG8_WAIT_VR do { if constexpr (Epi::NSTORE == 16) PG8_WAIT_V(24); else if constexpr (Epi::NSTORE == 8) PG8_WAIT_V(16); else { static_assert(Epi::NSTORE == 4 || Epi::NSTORE == 8 || Epi::NSTORE == 16, "NSTORE"); PG8_WAIT_V(12); } } while (0)
#define PG8_BAR __builtin_amdgcn_s_barrier()
#define PG8_SCHED __builtin_amdgcn_sched_barrier(0)
    Unit cur, nxt, nn; int ui = 0;
    if (!S.next(0, cur)) return;
    f32x4 acc[2][2][4][2];
    if constexpr (!FP8) {
#pragma unroll
    for (int a = 0; a < 2; ++a)
#pragma unroll
        for (int b = 0; b < 2; ++b)
#pragma unroll
            for (int m = 0; m < 4; ++m)
#pragma unroll
                for (int n = 0; n < 2; ++n) acc[a][b][m][n] = (f32x4){0.f, 0.f, 0.f, 0.f};
    }
    bf16x8 At[4][2], B0[2][2], B1[2][2];
    unsigned ca[2][2], na[2][2]; int ix[2][2];
    S.a_rows(cur, Rp, ix);
#pragma unroll
    for (int h = 0; h < 2; ++h)
#pragma unroll
        for (int i = 0; i < 2; ++i) ca[h][i] = (unsigned)ix[h][i] * rowb + cb[i];
    bool has1 = S.next(1, nxt);
    if (has1) S.a_rows(nxt, Rp, ix);
    const char* cB = cur.B;
    if constexpr (SP2) {
        PG8_STAGEB(PG8_SB(0, 0), cB, 0); PG8_STAGEB(PG8_SB(0, 1), cB, 1); PG8_STAGEA(PG8_SA(0, 0), 0, ca[0]); PG8_STAGEA(PG8_SA(0, 1), 0, ca[1]);
        if (wr == 1) PG8_BAR;
        PG8_WAIT_V(2); PG8_BAR;
        PG8_STAGEB(PG8_SB(1, 0), cB + kstep, 0); PG8_STAGEA(PG8_SA(1, 0), kstep, ca[0]); PG8_STAGEB(PG8_SB(1, 1), cB + kstep, 1);
        PG8_WAIT_V(6); PG8_BAR;
        if constexpr (FP8) { PG8_STAGEA(PG8_SA(1, 1), kstep, ca[1]);
          u32x4* dz = (u32x4*)dummy + (size_t)(blockIdx.x * 512 + tid) * 16;
#pragma unroll
          for (int q_ = 0; q_ < Epi::NSTORE; ++q_) dz[q_] = (u32x4){0u, 0u, 0u, 0u}; asm volatile("" ::: "memory"); }
    } else {
    PG8_STAGEB(PG8_SB(0, 0), cB, 0); PG8_STAGEA(PG8_SA(0, 0), 0, ca[0]); PG8_STAGEB(PG8_SB(0, 1), cB, 1); PG8_STAGEA(PG8_SA(0, 1), 0, ca[1]);
    if (wr == 1) PG8_BAR;
    PG8_WAIT_V(4); PG8_BAR;
    PG8_STAGEB(PG8_SB(1, 0), cB + kstep, 0); PG8_STAGEA(PG8_SA(1, 0), kstep, ca[0]); PG8_STAGEB(PG8_SB(1, 1), cB + kstep, 1);
    PG8_WAIT_V(6); PG8_BAR;
    }
    for (;;) {
        const bool has_next = has1;
#pragma unroll
        for (int h = 0; h < 2; ++h)
#pragma unroll
            for (int i = 0; i < 2; ++i) na[h][i] = has_next ? ((unsigned)ix[h][i] * rowb + cb[i]) : ca[h][i];
        bool has2 = false;
        if (has_next) { has2 = S.next(ui + 2, nn); if (has2) S.a_rows(nn, Rp, ix); }
        const char* nB = has_next ? nxt.B : cB;
        if constexpr (SP2) {
            if constexpr (FP8) {
                const size_t k1 = kstep, k2 = 2 * kstep, k3 = 3 * kstep;
                const unsigned (&sa0)[2] = ca[0]; const unsigned (&sa1)[2] = ca[1];
                const char* b2 = cB + k2; const char* b3 = b2 + kstep;
            PG8_LDB(B0, 0, 0); PG8_LDB(B1, 0, 1); PG8_SCHED; PG8_LDA(At, 0, 0);
            PG8_WAIT_VR;
            PG8_WAIT_L(0); PG8_BAR; PG8_MMA0(0, 0, At, B0); PG8_MMA0(0, 1, At, B1); PG8_BAR; PG8_SCHED;
            PG8_LDA(At, 0, 1); PG8_STAGEB(PG8_SB(0, 0), b2, 0); PG8_STAGEB(PG8_SB(0, 1), b2, 1); PG8_STAGEA(PG8_SA(0, 0), k2, sa0);
            PG8_WAIT_VR;
            PG8_WAIT_L(0); PG8_BAR; PG8_MMA0(1, 0, At, B0); PG8_MMA0(1, 1, At, B1); PG8_BAR; PG8_SCHED;
            PG8_LDB(B0, 1, 0); PG8_LDB(B1, 1, 1); PG8_SCHED; PG8_LDA(At, 1, 0); PG8_STAGEA(PG8_SA(0, 1), k2, sa1);
            PG8_WAIT_VR; PG8_WAIT_L(0); PG8_BAR; PG8_MMA(0, 0, At, B0); PG8_MMA(0, 1, At, B1); PG8_BAR; PG8_SCHED;
            PG8_LDA(At, 1, 1); PG8_STAGEB(PG8_SB(1, 0), b3, 0); PG8_STAGEB(PG8_SB(1, 1), b3, 1); PG8_STAGEA(PG8_SA(1, 0), k3, sa0);
            PG8_WAIT_V(8); PG8_WAIT_L(0); PG8_BAR; PG8_MMA(1, 0, At, B0); PG8_MMA(1, 1, At, B1); PG8_BAR; PG8_SCHED;
            }
        for (int t = FP8 ? 2 : 0; t < nt; t += 2) {
            const bool last = (t == nt - 2);
            const size_t k1 = (size_t)(t + 1) * kstep;
            const size_t k2 = last ? (size_t)0 : (size_t)(t + 2) * kstep, k3 = k2 + kstep;
            unsigned sa0[2], sa1[2];
#pragma unroll
            for (int i = 0; i < 2; ++i) { sa0[i] = last ? na[0][i] : ca[0][i]; sa1[i] = last ? na[1][i] : ca[1][i]; }
            const char* b2 = last ? nB : cB + k2; const char* b3 = b2 + kstep;
            PG8_LDB(B0, 0, 0); PG8_LDB(B1, 0, 1); PG8_SCHED; PG8_LDA(At, 0, 0); PG8_STAGEA(PG8_SA(1, 1), k1, ca[1]);
            PG8_WAIT_V(8);
            PG8_WAIT_L(0); PG8_BAR; PG8_MMA(0, 0, At, B0); PG8_MMA(0, 1, At, B1); PG8_BAR; PG8_SCHED;
            PG8_LDA(At, 0, 1); PG8_STAGEB(PG8_SB(0, 0), b2, 0); PG8_STAGEB(PG8_SB(0, 1), b2, 1); PG8_STAGEA(PG8_SA(0, 0), k2, sa0);
            PG8_WAIT_V(8);
            PG8_WAIT_L(0); PG8_BAR; PG8_MMA(1, 0, At, B0); PG8_MMA(1, 1, At, B1); PG8_BAR; PG8_SCHED;
            PG8_LDB(B0, 1, 0); PG8_LDB(B1, 1, 1); PG8_SCHED; PG8_LDA(At, 1, 0); PG8_STAGEA(PG8_SA(0, 1), k2, sa1);
            PG8_WAIT_V(8); PG8_WAIT_L(0); PG8_BAR; PG8_MMA(0, 0, At, B0); PG8_MMA(0, 1, At, B1); PG8_BAR; PG8_SCHED;
            PG8_LDA(At, 1, 1); PG8_STAGEB(PG8_SB(1, 0), b3, 0); PG8_STAGEB(PG8_SB(1, 1), b3, 1); PG8_STAGEA(PG8_SA(1, 0), k3, sa0);
            PG8_WAIT_V(8); PG8_WAIT_L(0); PG8_BAR; PG8_MMA(1, 0, At, B0); PG8_MMA(1, 1, At, B1); PG8_BAR; PG8_SCHED;
        }
        } else {
        for (int t = 0; t < nt; t += 2) {
            const bool last = (t == nt - 2);
            const size_t k1 = (size_t)(t + 1) * kstep;
            const size_t k2 = last ? (size_t)0 : (size_t)(t + 2) * kstep, k3 = k2 + kstep;
            unsigned sa0[2], sa1[2];
#pragma unroll
            for (int i = 0; i < 2; ++i) { sa0[i] = last ? na[0][i] : ca[0][i]; sa1[i] = last ? na[1][i] : ca[1][i]; }
            const char* b2 = last ? nB : cB + k2; const char* b3 = b2 + kstep;
            PG8_LDB(B0, 0, 0); PG8_SCHED; PG8_LDA(At, 0, 0); PG8_STAGEA(PG8_SA(1, 1), k1, ca[1]);
            PG8_WAIT_L(8); PG8_BAR; PG8_WAIT_L(0); PG8_MMA(0, 0, At, B0); PG8_BAR; PG8_SCHED;
            PG8_LDB(B1, 0, 1); PG8_STAGEB(PG8_SB(0, 0), b2, 0);
            PG8_BAR; PG8_WAIT_L(0); PG8_MMA(0, 1, At, B1); PG8_BAR;
            PG8_LDA(At, 0, 1); PG8_STAGEA(PG8_SA(0, 0), k2, sa0);
            PG8_BAR; PG8_WAIT_L(0); PG8_MMA(1, 0, At, B0); PG8_BAR; PG8_SCHED;
            PG8_STAGEB(PG8_SB(0, 1), b2, 1);
            PG8_WAIT_V(6); PG8_BAR; PG8_MMA(1, 1, At, B1); PG8_BAR;
            PG8_LDB(B0, 1, 0); PG8_SCHED; PG8_LDA(At, 1, 0); PG8_STAGEA(PG8_SA(0, 1), k2, sa1);
            PG8_WAIT_L(8); PG8_BAR; PG8_WAIT_L(0); PG8_MMA(0, 0, At, B0); PG8_BAR; PG8_SCHED;
            PG8_LDB(B1, 1, 1); PG8_STAGEB(PG8_SB(1, 0), b3, 0);
            PG8_BAR; PG8_WAIT_L(0); PG8_MMA(0, 1, At, B1); PG8_BAR;
            PG8_LDA(At, 1, 1); PG8_STAGEA(PG8_SA(1, 0), k3, sa0);
            PG8_BAR; PG8_WAIT_L(0); PG8_MMA(1, 0, At, B0); PG8_BAR; PG8_SCHED;
            PG8_STAGEB(PG8_SB(1, 1), b3, 1);
            PG8_WAIT_V(6); PG8_BAR; PG8_MMA(1, 1, At, B1); PG8_BAR;
        }
        }
        if constexpr (FP8) PG8_STAGEA(PG8_SA(1, 1), kstep, na[1]);
        if constexpr (ALIGN_EPI) { if (wr == 0) PG8_BAR; }
        if constexpr (FP8) asm volatile("s_nop 15\n\ts_nop 15" ::: "memory");
        E(acc, cur, wr, wc, fr, fq);
        if (!has_next) break;
        if constexpr (!FP8) {
#pragma unroll
        for (int a = 0; a < 2; ++a)
#pragma unroll
            for (int b = 0; b < 2; ++b)
#pragma unroll
                for (int m = 0; m < 4; ++m)
#pragma unroll
                    for (int n = 0; n < 2; ++n) acc[a][b][m][n] = (f32x4){0.f, 0.f, 0.f, 0.f};
        }
        cur = nxt; nxt = nn; has1 = has2; cB = nB; ++ui;
        if constexpr (ALIGN_EPI) { if (wr == 1) PG8_BAR; }
#pragma unroll
        for (int h = 0; h < 2; ++h)
#pragma unroll
            for (int i = 0; i < 2; ++i) ca[h][i] = na[h][i];
    }
    PG8_WAIT_V(0);
    if constexpr (!ALIGN_EPI) { if (wr == 0) PG8_BAR; }
    PG8_BAR;
#undef PG8_SA
#undef PG8_SB
#undef PG8_STAGEA
#undef PG8_STAGEB
#undef PG8_LDA
#undef PG8_LDB
#undef PG8_MMA
#undef PG8_CAT8
#undef PG8_WAIT_V
#undef PG8_WAIT_VR
#undef PG8_MMA0
#undef PG8_WAIT_L
#undef PG8_BAR
#undef PG8_SCHED
}
}

struct TrItem { const float* W; int ldw, k0, n0; bf16_t* WT; int ldk, drow0; bf16_t* WL; float sc8; };
__device__ __forceinline__ void tr_load(const TrItem& t, f32x4 (&v)[8], int lane) {
    const float* src = t.W + (size_t)(t.k0 + (lane >> 3)) * t.ldw + t.n0 + 4 * (lane & 7);
#pragma unroll
    for (int i = 0; i < 8; ++i) v[i] = *(const f32x4*)(src + (size_t)(8 * i) * t.ldw);
}
__device__ __forceinline__ void tr_store(const TrItem& t, const f32x4 (&v)[8], LAS float* scr, int lane) {
    LAS float* wp = scr + (lane >> 3) * 33 + 4 * (lane & 7);
#pragma unroll
    for (int i = 0; i < 8; ++i) { wp[(8 * i) * 33 + 0] = v[i][0]; wp[(8 * i) * 33 + 1] = v[i][1]; wp[(8 * i) * 33 + 2] = v[i][2]; wp[(8 * i) * 33 + 3] = v[i][3]; }
    LDS_WAIT(); asm volatile("" ::: "memory");
    const int c = lane & 7;
#pragma unroll
    for (int j = 0; j < 4; ++j) { const int n = (lane >> 3) + 8 * j; const LAS float* sp = scr + (8 * c) * 33 + n;
        float x[8];
#pragma unroll
        for (int q = 0; q < 8; ++q) x[q] = sp[q * 33];
        if (t.WL) {
            const int e = t.drow0 + n, k = t.k0 + 8 * c; const size_t off = ((size_t)(((k >> 10) * 4 + (e >> 4)) * 32 + ((k >> 5) & 31)) * 64 + ((k >> 3) & 3) * 16 + (e & 15)) * 8;
            unsigned hw[4], lw[4];
#pragma unroll
            for (int q = 0; q < 4; ++q) { hw[q] = cvt_pk_bf16(x[2 * q], x[2 * q + 1]); lw[q] = cvt_pk_bf16(x[2 * q] - bf_lo(hw[q]), x[2 * q + 1] - bf_hi(hw[q])); }
            *(u32x4*)(t.WT + off) = (u32x4){hw[0], hw[1], hw[2], hw[3]}; *(u32x4*)(t.WL + off) = (u32x4){lw[0], lw[1], lw[2], lw[3]}; continue; }
        if (t.sc8 > 0.f) { int d0 = 0, d1 = 0; const float s8 = t.sc8;
            d0 = __builtin_amdgcn_cvt_pk_fp8_f32(x[0] * s8, x[1] * s8, d0, false); d0 = __builtin_amdgcn_cvt_pk_fp8_f32(x[2] * s8, x[3] * s8, d0, true);
            d1 = __builtin_amdgcn_cvt_pk_fp8_f32(x[4] * s8, x[5] * s8, d1, false); d1 = __builtin_amdgcn_cvt_pk_fp8_f32(x[6] * s8, x[7] * s8, d1, true);
            *(u32x2*)((unsigned char*)t.WT + (size_t)(t.drow0 + n) * t.ldk + t.k0 + 8 * c) = (u32x2){(unsigned)d0, (unsigned)d1}; continue; }
        unsigned hw[4];
#pragma unroll
        for (int q = 0; q < 4; ++q) hw[q] = cvt_pk_bf16(x[2 * q], x[2 * q + 1]);
        *(u32x4*)(t.WT + (size_t)(t.drow0 + n) * t.ldk + t.k0 + 8 * c) = (u32x4){hw[0], hw[1], hw[2], hw[3]}; }
    LDS_WAIT(); asm volatile("" ::: "memory");
}
template <class Dec>
__device__ __forceinline__ void tr_run(const Dec& dec, int first, int stride, int end, LAS float* scr, int lane) {
    if (first >= end) return;
    f32x4 va[8], vb[8]; TrItem ia, ib;
    dec(first, ia); tr_load(ia, va, lane);
    for (int it = first; ; it += 2 * stride) {
        const bool hb = it + stride < end;
        if (hb) { dec(it + stride, ib); tr_load(ib, vb, lane); }
        tr_store(ia, va, scr, lane);
        if (!hb) break;
        const bool ha = it + 2 * stride < end;
        if (ha) { dec(it + 2 * stride, ia); tr_load(ia, va, lane); }
        tr_store(ib, vb, scr, lane);
        if (!ha) break;
    }
}

__device__ __forceinline__ void phase_prologue(const Params& p, LAS unsigned char* lds, int bid, int nblk) {
    const int tid = threadIdx.x, lane = tid & 63, wave = __builtin_amdgcn_readfirstlane(tid >> 6);
    unsigned char* ws = p.ws;
    float* mod = (float*)(ws + WS_MOD);
    for (int cg = bid; cg < MODW / 64; cg += nblk) {
        LAS float* sl = (LAS float*)lds;
        for (int i = tid; i < NBATCH * DM; i += NTHREADS) sl[i] = fsilu(p.c[i]);
        __syncthreads();
        const int n = cg * 64 + lane, k0 = wave * 256;
        float a[8] = {0.f, 0.f, 0.f, 0.f, 0.f, 0.f, 0.f, 0.f};
        for (int k = k0; k < k0 + 256; k += 32) {
            float w[32];
#pragma unroll
            for (int u = 0; u < 32; ++u) w[u] = p.w_ada[(size_t)(k + u) * MODW + n];
#pragma unroll
            for (int u = 0; u < 32; ++u)
#pragma unroll
                for (int b = 0; b < 8; ++b) a[b] += sl[b * DM + k + u] * w[u];
        }
        LAS float* part = sl + NBATCH * DM;
#pragma unroll
        for (int b = 0; b < 8; ++b) part[(wave * 8 + b) * 64 + lane] = a[b];
        __syncthreads();
        { const int b = tid >> 6; float s = 0.f;
#pragma unroll
            for (int w = 0; w < 8; ++w) s += part[(w * 8 + b) * 64 + lane];
            mod[b * MODW + cg * 64 + lane] = s + p.b_ada[cg * 64 + lane]; }
        __syncthreads();
    }
    if (bid == nblk - 1) { float* gw = (float*)(ws + WS_GATEW);
        for (int i = tid; i < 8 * DM; i += NTHREADS) { const int g = i >> 11, k = i & (DM - 1); gw[i] = p.w_in[(size_t)k * INW + INWM + g]; } }
    LAS float* scr = (LAS float*)(lds + wave * 16384);
    const int gw = bid * NWAVES + wave, NGW = nblk * NWAVES;
    constexpr int I_IN = 32 * 224, I_OUT = 32 * 64, I_SG = 32 * 16, I_SD = 8 * 64, I_R = 32 * 2;
    constexpr int NIT = I_IN + I_OUT + 2 * I_SG + I_SD + I_R;
    bf16_t* WIN = (bf16_t*)(ws + WS_WIN); bf16_t* WOUT = (bf16_t*)(ws + WS_WOUT);
    bf16_t* WGUs = (bf16_t*)(ws + WS_WGU + (size_t)NE * 1024 * DM); bf16_t* WDs = (bf16_t*)(ws + WS_WD + (size_t)NE * DM * FE);
    bf16_t* WRH = (bf16_t*)(ws + WS_WRHI); bf16_t* WRL = (bf16_t*)(ws + WS_WRLO);
    auto dec = [&](int it, TrItem& t) {
        int r = it; t.WL = nullptr;
        if (r < I_IN) { const int kb = r / 224, nb = r % 224; t = TrItem{p.w_in, INW, 64 * kb, 32 * nb, WIN, DM, 32 * nb, nullptr, 0.f}; return; } r -= I_IN;
        if (r < I_OUT) { const int kb = r / 64, nb = r % 64; t = TrItem{p.w_out, DM, 64 * kb, 32 * nb, WOUT, DM, 32 * nb, nullptr, 0.f}; return; } r -= I_OUT;
        if (r < I_SG) { const int kb = r / 16, nb = r % 16, n0 = 32 * nb; t = TrItem{p.ws_gate, FE, 64 * kb, n0, WGUs, DM, 256 * (n0 >> 7) + (n0 & 127), nullptr, 64.f}; return; } r -= I_SG;
        if (r < I_SG) { const int kb = r / 16, nb = r % 16, n0 = 32 * nb; t = TrItem{p.ws_up, FE, 64 * kb, n0, WGUs, DM, 256 * (n0 >> 7) + 128 + (n0 & 127), nullptr, 64.f}; return; } r -= I_SG;
        if (r < I_SD) { const int kb = r / 64, nb = r % 64; t = TrItem{p.ws_down, DM, 64 * kb, 32 * nb, WDs, FE, 32 * nb, nullptr, 64.f}; return; } r -= I_SD;
        { const int kb = r / 2, nb = r % 2; t = TrItem{p.w_router, NE, 64 * kb, 32 * nb, WRH, DM, 32 * nb, WRL, 0.f}; }
    };
    tr_run(dec, gw, NGW, NIT, scr, lane);
}

__device__ __forceinline__ void expert_convert(const Params& p, LAS unsigned char* lds, int qidx = 0) {
    const int lane = threadIdx.x & 63, wave = __builtin_amdgcn_readfirstlane(threadIdx.x >> 6);
    unsigned* q = (unsigned*)(p.ws + WS_CTL) + CW_QUEUE + 64 * qidx;
    LAS float* scr = (LAS float*)(lds + wave * 16384);
    unsigned char* WGU = p.ws + WS_WGU; unsigned char* WD = p.ws + WS_WD;
    constexpr unsigned NITEMS = 64u * 1536u, CH = 16u;
    auto dec = [&](int it, TrItem& t) {
        const int e = it / 1536; int r = it % 1536;
        if (r < 512) { const int kb = r / 16, nb = r % 16, n0 = 32 * nb; t = TrItem{p.w_gate + (size_t)e * DM * FE, FE, 64 * kb, n0, (bf16_t*)(WGU + (size_t)e * 1024 * DM), DM, 256 * (n0 >> 7) + (n0 & 127), nullptr, 64.f}; }
        else if (r < 1024) { r -= 512; const int kb = r / 16, nb = r % 16, n0 = 32 * nb; t = TrItem{p.w_up + (size_t)e * DM * FE, FE, 64 * kb, n0, (bf16_t*)(WGU + (size_t)e * 1024 * DM), DM, 256 * (n0 >> 7) + 128 + (n0 & 127), nullptr, 64.f}; }
        else { r -= 1024; const int kb = r / 64, nb = r % 64; t = TrItem{p.w_down + (size_t)e * FE * DM, DM, 64 * kb, 32 * nb, (bf16_t*)(WD + (size_t)e * DM * FE), FE, 32 * nb, nullptr, 64.f}; }
    };
    for (;;) {
        unsigned base = 0; if (lane == 0) base = __hip_atomic_fetch_add(q, CH, __ATOMIC_RELAXED, __HIP_MEMORY_SCOPE_AGENT);
        base = __builtin_amdgcn_readfirstlane(base);
        if (base >= NITEMS) break;
        tr_run(dec, (int)base, 1, (int)(base + CH), scr, lane);
    }
}

__device__ __forceinline__ void phase_modulate(const Params& p, LAS unsigned char* lds, int bid, int nblk) {
    const int tid = threadIdx.x, lane = tid & 63, wave = __builtin_amdgcn_readfirstlane(tid >> 6);
    const float* mod = (const float*)(p.ws + WS_MOD); const float* gwg = (const float*)(p.ws + WS_GATEW);
    float* gates = (float*)(p.ws + WS_GATES); bf16_t* U1 = (bf16_t*)(p.ws + WS_RA);
    LAS float* sc = (LAS float*)lds; LAS float* sh = sc + DM; LAS float* gw = sh + DM;
    const int rows_per = T / nblk;
    const int row_lo = bid * rows_per, b = row_lo / SEQ;
    for (int i = tid; i < DM; i += NTHREADS) { sh[i] = mod[b * MODW + i]; sc[i] = 1.0f + mod[b * MODW + DM + i]; }
    for (int i = tid; i < 8 * DM; i += NTHREADS) gw[i] = gwg[i];
    __syncthreads();
    for (int r0 = row_lo + 2 * wave; r0 < row_lo + rows_per; r0 += 2 * NWAVES) {
        f32x4 xv[2][8];
#pragma unroll
        for (int q = 0; q < 2; ++q)
#pragma unroll
            for (int j = 0; j < 8; ++j) xv[q][j] = __builtin_nontemporal_load((const f32x4*)(p.x + (size_t)(r0 + q) * DM) + lane + 64 * j);
#pragma unroll
        for (int q = 0; q < 2; ++q) {
            const int r = r0 + q;
            u32x2* ur = (u32x2*)(U1 + (size_t)r * DM) + lane;
            float a[8] = {0.f, 0.f, 0.f, 0.f, 0.f, 0.f, 0.f, 0.f};
#pragma unroll
            for (int j = 0; j < 8; ++j) {
                const int col = 4 * lane + 256 * j;
                const f32x4 s = *(const LAS f32x4*)(sc + col), h = *(const LAS f32x4*)(sh + col);
                const f32x4 u = xv[q][j] * s + h;
                ur[64 * j] = (u32x2){cvt_pk_bf16(u[0], u[1]), cvt_pk_bf16(u[2], u[3])};
#pragma unroll
                for (int g = 0; g < 8; ++g) { const f32x4 w = *(const LAS f32x4*)(gw + g * DM + col); a[g] += (u[0] * w[0] + u[1] * w[1]) + (u[2] * w[2] + u[3] * w[3]); }
                asm volatile("" ::: "memory");
            }
#pragma unroll
            for (int g = 0; g < 8; ++g) a[g] = wave_sum(a[g]);
            float o = a[0];
#pragma unroll
            for (int g = 1; g < 8; ++g) o = (lane == g) ? a[g] : o;
            if (lane < 8) gates[(size_t)r * 8 + lane] = o + p.b_gates[lane];
        }
    }
}

__device__ __forceinline__ void retention_naive(const Params& p, LAS unsigned char* lds, int b, int h) {
    const int tid = threadIdx.x, v = tid & 255, dh = tid >> 8;
    const bf16_t* proj = (const bf16_t*)(p.ws + WS_RB); bf16_t* outp = (bf16_t*)(p.ws + WS_RC);
    constexpr int TB = 8;
    LAS float* qs = (LAS float*)lds; LAS float* ks = qs + TB * 256; LAS float* vs = ks + TB * 256; LAS float* red = vs + TB * 256;
    const float g = 1.0f - __builtin_amdgcn_exp2f(-5.0f - (float)h);
    float S[128];
#pragma unroll
    for (int d = 0; d < 128; ++d) S[d] = 0.f;
    for (int t0 = 0; t0 < SEQ; t0 += TB) {
        for (int i = tid; i < TB * 256; i += NTHREADS) { const int s = i >> 8, c = i & 255; const size_t rb = (size_t)(b * SEQ + t0 + s) * INWM;
            qs[i] = bf2f(proj[rb + PC_RQ + h * 256 + c]); ks[i] = bf2f(proj[rb + PC_RK + h * 256 + c]); vs[i] = bf2f(proj[rb + PC_RV + h * 256 + c]); }
        __syncthreads();
        for (int s = 0; s < TB; ++s) {
            const float vv = vs[s * 256 + v]; float o = 0.f;
            const LAS f32x4* q4 = (const LAS f32x4*)(qs + s * 256 + dh * 128); const LAS f32x4* k4 = (const LAS f32x4*)(ks + s * 256 + dh * 128);
#pragma unroll
            for (int d4 = 0; d4 < 32; ++d4) { const f32x4 q = q4[d4], k = k4[d4];
#pragma unroll
                for (int j = 0; j < 4; ++j) { S[4 * d4 + j] = g * S[4 * d4 + j] + k[j] * vv; o += q[j] * S[4 * d4 + j]; } }
            red[(s * 2 + dh) * 256 + v] = o;
        }
        __syncthreads();
        for (int i = tid; i < TB * 256; i += NTHREADS) { const int s = i >> 8, c = i & 255;
            const float o = red[(s * 2) * 256 + c] + red[(s * 2 + 1) * 256 + c];
            outp[(size_t)(b * SEQ + t0 + s) * DM + h * 256 + c] = (bf16_t)(cvt_pk_bf16(o, 0.f) & 0xffffu); }
        __syncthreads();
    }
}
__device__ __forceinline__ void mlstm_naive(const Params& p, LAS unsigned char* lds, int b, int h) {
    const int tid = threadIdx.x, v = tid & 255, dh = tid >> 8;
    const bf16_t* proj = (const bf16_t*)(p.ws + WS_RB); bf16_t* outp = (bf16_t*)(p.ws + WS_RC); const float* gates = (const float*)(p.ws + WS_GATES);
    constexpr int TB = 8;
    LAS float* raw = (LAS float*)lds;
    LAS float* qs = raw + (TB + 3) * 256;
    LAS float* ks = qs + TB * 128;
    LAS float* vs = ks + TB * 128;
    LAS float* red = vs + TB * 256;
    LAS float* rden = red + TB * 2 * 256;
    LAS float* gsc = rden + TB * 2;
    float C[64], n[64];
#pragma unroll
    for (int d = 0; d < 64; ++d) { C[d] = 0.f; n[d] = 0.f; }
    float mrun = 0.f;
    for (int t0 = 0; t0 < SEQ; t0 += TB) {
        for (int i = tid; i < (TB + 3) * 256; i += NTHREADS) { const int s = i >> 8, c = i & 255; const int t = t0 - 3 + s;
            const int col = (c < 128) ? (PC_MQK + h * 128 + c) : (PC_MQK + 512 + h * 128 + (c - 128));
            raw[i] = (t >= 0) ? bf2f(proj[(size_t)(b * SEQ + t) * INWM + col]) : 0.f; }
        for (int i = tid; i < TB * 256; i += NTHREADS) { const int s = i >> 8, c = i & 255; vs[i] = bf2f(proj[(size_t)(b * SEQ + t0 + s) * INWM + PC_MV + h * 256 + c]); }
        __syncthreads();
        for (int i = tid; i < TB * 256; i += NTHREADS) { const int s = i >> 8, c = i & 255;
            const int ch = (c < 128) ? (h * 128 + c) : (512 + h * 128 + (c - 128));
            float a = p.conv_b[ch];
#pragma unroll
            for (int w = 0; w < 4; ++w) a += raw[(s + w) * 256 + c] * p.conv_w[w * 1024 + ch];
            a = fsilu(a);
            if (c < 128) qs[s * 128 + c] = a * 0.08838834764831845f; else ks[s * 128 + (c - 128)] = a; }
        if (tid == 0) { float m = mrun;
            for (int s = 0; s < TB; ++s) { const size_t r = (size_t)(b * SEQ + t0 + s) * 8; const float ip = gates[r + h], fp = gates[r + 4 + h];
                const float lf = fminf(fp, 0.f) - log1pf(__expf(-fabsf(fp)));
                const float mn = fmaxf(lf + m, ip);
                gsc[s * 3 + 0] = __expf(lf + m - mn); gsc[s * 3 + 1] = __expf(ip - mn); gsc[s * 3 + 2] = __expf(-mn); m = mn; }
            gsc[TB * 3] = m; }
        __syncthreads();
        mrun = gsc[TB * 3];
        for (int s = 0; s < TB; ++s) {
            const float fs = gsc[s * 3], is = gsc[s * 3 + 1];
            const float vv = vs[s * 256 + v] * is; float num = 0.f, den = 0.f;
            const LAS f32x4* q4 = (const LAS f32x4*)(qs + s * 128 + dh * 64); const LAS f32x4* k4 = (const LAS f32x4*)(ks + s * 128 + dh * 64);
#pragma unroll
            for (int d4 = 0; d4 < 16; ++d4) { const f32x4 q = q4[d4], k = k4[d4];
#pragma unroll
                for (int j = 0; j < 4; ++j) { C[4 * d4 + j] = fs * C[4 * d4 + j] + k[j] * vv; n[4 * d4 + j] = fs * n[4 * d4 + j] + is * k[j];
                    num += q[j] * C[4 * d4 + j]; den += q[j] * n[4 * d4 + j]; } }
            red[(s * 2 + dh) * 256 + v] = num;
            if (v == 0) rden[s * 2 + dh] = den;
        }
        __syncthreads();
        for (int i = tid; i < TB * 256; i += NTHREADS) { const int s = i >> 8, c = i & 255;
            const float num = red[(s * 2) * 256 + c] + red[(s * 2 + 1) * 256 + c], den = rden[s * 2] + rden[s * 2 + 1];
            const float o = num / fmaxf(fabsf(den), gsc[s * 3 + 2]);
            outp[(size_t)(b * SEQ + t0 + s) * DM + 1024 + h * 256 + c] = (bf16_t)(cvt_pk_bf16(o, 0.f) & 0xffffu); }
        __syncthreads();
    }
}
typedef short s16x4 __attribute__((ext_vector_type(4)));
__device__ __forceinline__ bf16x8 cat4(s16x4 a, s16x4 b) { return __builtin_shufflevector(a, b, 0, 1, 2, 3, 4, 5, 6, 7); }
__device__ __forceinline__ s16x4 tr_read(LAS const unsigned char* q) { return __builtin_amdgcn_ds_read_tr16_b64_v4i16((LAS s16x4*)q); }
__device__ __forceinline__ void unpack8(const u32x4 v, float (&x)[8]) { x[0] = bf_lo(v.x); x[1] = bf_hi(v.x); x[2] = bf_lo(v.y); x[3] = bf_hi(v.y); x[4] = bf_lo(v.z); x[5] = bf_hi(v.z); x[6] = bf_lo(v.w); x[7] = bf_hi(v.w); }
__device__ __forceinline__ u32x4 pack8(const float (&x)[8]) { return (u32x4){cvt_pk_bf16(x[0], x[1]), cvt_pk_bf16(x[2], x[3]), cvt_pk_bf16(x[4], x[5]), cvt_pk_bf16(x[6], x[7])}; }

#define BAR_LDS() do { asm volatile("s_waitcnt lgkmcnt(0)" ::: "memory"); __builtin_amdgcn_s_barrier(); asm volatile("" ::: "memory"); } while (0)
__device__ __forceinline__ void phase_conv(const Params& p, LAS unsigned char* lds, int bid, int nblk) {
    const int tid = threadIdx.x;
    const bf16_t* proj = (const bf16_t*)(p.ws + WS_RB); bf16_t* outc = (bf16_t*)(p.ws + WS_CONV);
    LAS float* cw = (LAS float*)lds;
    for (int i = tid; i < 5 * 1024; i += NTHREADS) cw[i] = (i < 4096) ? p.conv_w[i] : p.conv_b[i - 4096];
    __syncthreads();
    const int rows_per = T / nblk, row_lo = bid * rows_per;
    for (int it = tid; it < (rows_per / 4) * 128; it += NTHREADS) {
        const int rq = it >> 7, cg = it & 127, c0 = 8 * cg, t0 = row_lo + 4 * rq, s0 = t0 & (SEQ - 1);
        float x[7][8];
#pragma unroll
        for (int u = 0; u < 7; ++u) { u32x4 v = (u32x4){0u, 0u, 0u, 0u}; if (s0 - 3 + u >= 0) v = *(const u32x4*)(proj + (size_t)(t0 - 3 + u) * INWM + PC_MQK + c0); unpack8(v, x[u]); }
        f32x4 wv[5][2];
#pragma unroll
        for (int u = 0; u < 5; ++u) { wv[u][0] = *(const LAS f32x4*)(cw + u * 1024 + c0); wv[u][1] = *(const LAS f32x4*)(cw + u * 1024 + c0 + 4); }
        const float qs = (c0 < 512) ? 0.08838834764831845f : 1.0f;
#pragma unroll
        for (int r = 0; r < 4; ++r) { float a[8];
#pragma unroll
            for (int e = 0; e < 8; ++e) { float acc = wv[4][e >> 2][e & 3];
#pragma unroll
                for (int u = 0; u < 4; ++u) acc += x[r + u][e] * wv[u][e >> 2][e & 3];
                a[e] = fsilu(acc) * qs; }
            *(u32x4*)(outc + (size_t)(t0 + r) * 1024 + c0) = pack8(a); }
    }
}

template <int DK, bool ML>
__device__ __forceinline__ void chain_mfma(const Params& p, LAS unsigned char* lds, int b, int h, int vh, float* gscr) {
    constexpr int PQ = DK * 2 + 16, PV = 272, PP = 144, NDT = DK / 16, NKS = DK / 32, NC = SEQ / 64, NPQ = DK / 64;
    constexpr int O_QS = 0, O_KS = 64 * PQ, O_VS = 128 * PQ, O_VP = O_VS + 64 * PV, O_PS = O_VP + 64 * PV, O_OB = O_PS + 64 * PP, O_VEC = O_OB + 64 * PV;
    static_assert(O_VEC + 8192 <= BARW_OFF, "chain LDS map");
    LAS float* rowterm = (LAS float*)(lds + O_VEC); LAS float* cterm = rowterm + 64; LAS float* winter = cterm + 64; LAS float* enm = winter + 64; LAS float* gkv = enm + 64;
    LAS float* cb63 = gkv + 64;
    LAS float* ccm = cb63 + 64;
    LAS float* cmp_ = ccm + 64;
    LAS float* cmn = cmp_ + 64;
    const int tid = threadIdx.x, lane = tid & 63, w = __builtin_amdgcn_readfirstlane(tid >> 6), r16 = lane & 15, kg = lane >> 4, q4 = r16 >> 2, p4 = lane & 3;
    const bf16_t* proj = (const bf16_t*)(p.ws + WS_RB); bf16_t* outp = (bf16_t*)(p.ws + WS_RC); const float* gates = (const float*)(p.ws + WS_GATES);
    const size_t row0 = (size_t)b * SEQ;
    const bf16_t* qsrc = ML ? ((const bf16_t*)(p.ws + WS_CONV) + h * 128) : (proj + PC_RQ + h * 256);
    const bf16_t* ksrc = ML ? ((const bf16_t*)(p.ws + WS_CONV) + 512 + h * 128) : (proj + PC_RK + h * 256);
    constexpr int QLD = ML ? 1024 : INWM;
    const int vcol = (ML ? PC_MV : PC_RV) + h * 256 + vh * 128, ocol = (ML ? 1024 : 0) + h * 256 + vh * 128;
    const float lg = ML ? 0.f : __log2f(1.0f - __builtin_amdgcn_exp2f(-5.0f - (float)h));
    f32x4 S[NDT], Sn[ML ? NDT : 1];
#pragma unroll
    for (int i = 0; i < NDT; ++i) S[i] = (f32x4){0.f, 0.f, 0.f, 0.f};
#pragma unroll
    for (int i = 0; i < (ML ? NDT : 1); ++i) Sn[i] = (f32x4){0.f, 0.f, 0.f, 0.f};
    float gst = 0.f;
    if (ML) {
        float bcr[8], ctr[8], cmr[8];
#pragma unroll
        for (int q = 0; q < 8; ++q) { const int c = w + 8 * q;
            const float gi_ = gates[(row0 + c * 64 + lane) * 8 + h], gf_ = gates[(row0 + c * 64 + lane) * 8 + 4 + h];
            const float lf = fminf(gf_, 0.f) - __logf(1.0f + __expf(-fabsf(gf_)));
            float bc = lf;
#pragma unroll
            for (int o = 1; o < 64; o <<= 1) { const float t = __shfl_up(bc, o); if (lane >= o) bc += t; }
            const float ct = gi_ - bc; float cm = ct;
#pragma unroll
            for (int o = 1; o < 64; o <<= 1) { const float t = __shfl_up(cm, o); if (lane >= o) cm = fmaxf(cm, t); }
            bcr[q] = bc; ctr[q] = ct; cmr[q] = cm;
            if (lane == 63) { cb63[c] = bc; ccm[c] = cm; } }
        __syncthreads();
        if (tid == 0) { float m = 0.f; for (int c = 0; c < NC; ++c) { cmp_[c] = m; const float mn = cb63[c] + fmaxf(m, ccm[c]); cmn[c] = mn; gscr[5 * SEQ + c] = __expf(cb63[c] + m - mn); m = mn; } }
        __syncthreads();
#pragma unroll
        for (int q = 0; q < 8; ++q) { const int c = w + 8 * q, f = c * 64 + lane; const float mp = cmp_[c], mn = cmn[c], b63 = cb63[c];
            const float m = bcr[q] + fmaxf(mp, cmr[q]);
            gscr[f] = bcr[q] - m; gscr[SEQ + f] = ctr[q]; gscr[2 * SEQ + f] = __expf(bcr[q] + mp - m); gscr[3 * SEQ + f] = __expf(-m); gscr[4 * SEQ + f] = __expf(b63 + ctr[q] - mn); }
    }
    u32x4 pq[NPQ], pk[NPQ], pv[2]; float g_rt = 0.f, g_ct = 0.f, g_wi = 0.f, g_en = 0.f, g_gk = 0.f, g_st = 0.f;
    int tv = tid;
    auto load_chunk = [&](int c) {
#pragma unroll
        for (int i = 0; i < NPQ; ++i) { const int id = tv + 512 * i, row = id / (DK / 8), pc = id % (DK / 8); const size_t ro = (row0 + c * 64 + row) * QLD + pc * 8;
            pq[i] = *(const u32x4*)(qsrc + ro); pk[i] = *(const u32x4*)(ksrc + ro); }
        if (ML) { const int f = c * 64 + lane;
            g_gk = gscr[4 * SEQ + f]; g_st = gscr[5 * SEQ + c];
            if (w == 0) { g_rt = gscr[f]; g_ct = gscr[SEQ + f]; g_wi = gscr[2 * SEQ + f]; g_en = gscr[3 * SEQ + f]; } }
#pragma unroll
        for (int i = 0; i < 2; ++i) { const int id = tv + 512 * i, row = id >> 4, pc = id & 15; pv[i] = *(const u32x4*)(proj + (row0 + c * 64 + row) * INWM + vcol + pc * 8); }
    };
    auto stage_chunk = [&]() {
#pragma unroll
        for (int i = 0; i < NPQ; ++i) { const int id = tv + 512 * i, row = id / (DK / 8), pc = id % (DK / 8);
            *(LAS u32x4*)(lds + O_QS + row * PQ + pc * 16) = pq[i]; *(LAS u32x4*)(lds + O_KS + row * PQ + pc * 16) = pk[i]; }
        if (ML) { if (w == 0) { rowterm[lane] = g_rt; cterm[lane] = g_ct; winter[lane] = g_wi; enm[lane] = g_en; gkv[lane] = g_gk; }
            gst = g_st; }
#pragma unroll
        for (int i = 0; i < 2; ++i) { const int id = tv + 512 * i, row = id >> 4, pc = id & 15;
            const float sc = ML ? __shfl(g_gk, row) : __builtin_amdgcn_exp2f((float)(63 - row) * lg);
            float x[8]; unpack8(pv[i], x);
#pragma unroll
            for (int e = 0; e < 8; ++e) x[e] *= sc;
            *(LAS u32x4*)(lds + O_VS + row * PV + pc * 16) = pv[i]; *(LAS u32x4*)(lds + O_VP + row * PV + pc * 16) = pack8(x); }
    };
    __syncthreads();
    load_chunk(0);
    stage_chunk();
    __syncthreads();
    for (int c = 0; c < NC; ++c) {
        asm volatile("" : "+v"(tv));
        if (c + 1 < NC) load_chunk(c + 1);
        {
            const int it = w >> 1;
            f32x4 sc[2] = {(f32x4){0.f, 0.f, 0.f, 0.f}, (f32x4){0.f, 0.f, 0.f, 0.f}};
            const LAS unsigned char* qb = lds + O_QS + (16 * it + r16) * PQ + (8 * kg) * 2;
            const LAS unsigned char* kb0 = lds + O_KS + (16 * (2 * (w & 1)) + r16) * PQ + (8 * kg) * 2;
            bf16x8 fa[2], fb0[2], fb1[2];
            fa[0] = *(const LAS bf16x8*)(qb); fb0[0] = *(const LAS bf16x8*)(kb0); fb1[0] = *(const LAS bf16x8*)(kb0 + 16 * PQ);
#pragma unroll
            for (int ks = 0; ks < NKS; ++ks) {
                if (ks + 1 < NKS) { fa[(ks + 1) & 1] = *(const LAS bf16x8*)(qb + 64 * (ks + 1)); fb0[(ks + 1) & 1] = *(const LAS bf16x8*)(kb0 + 64 * (ks + 1)); fb1[(ks + 1) & 1] = *(const LAS bf16x8*)(kb0 + 16 * PQ + 64 * (ks + 1)); }
                sc[0] = __builtin_amdgcn_mfma_f32_16x16x32_bf16(fa[ks & 1], fb0[ks & 1], sc[0], 0, 0, 0);
                sc[1] = __builtin_amdgcn_mfma_f32_16x16x32_bf16(fa[ks & 1], fb1[ks & 1], sc[1], 0, 0, 0);
                __builtin_amdgcn_sched_barrier(0);
            }
#pragma unroll
            for (int jj = 0; jj < 2; ++jj) { const int jt = 2 * (w & 1) + jj, j = 16 * jt + r16; const float ctj = ML ? cterm[j] : 0.f;
                f32x4 rt4 = (f32x4){0.f, 0.f, 0.f, 0.f}; if (ML) rt4 = *(const LAS f32x4*)(rowterm + 16 * it + 4 * kg);
#pragma unroll
                for (int r = 0; r < 4; ++r) { const int i = 16 * it + 4 * kg + r;
                    const float wgt = ML ? __expf(fminf(rt4[r] + ctj, 0.f)) : __builtin_amdgcn_exp2f((float)(i - j) * lg);
                    const float val = (j <= i) ? sc[jj][r] * wgt : 0.f;
                    *(LAS bf16_t*)(lds + O_PS + i * PP + j * 2) = (bf16_t)(cvt_pk_bf16(val, 0.f) & 0xffffu); }
            }
        }
        BAR_LDS();
        {
            bf16x8 bv[2], bvp[2], gkf[2];
#pragma unroll
            for (int ks = 0; ks < 2; ++ks) {
                const LAS unsigned char* a0 = lds + O_VS + (32 * ks + 8 * kg + q4) * PV + (16 * w) * 2 + 8 * p4;
                bv[ks] = cat4(tr_read(a0), tr_read(a0 + 4 * PV));
                const LAS unsigned char* a1 = lds + O_VP + (32 * ks + 8 * kg + q4) * PV + (16 * w) * 2 + 8 * p4;
                bvp[ks] = cat4(tr_read(a1), tr_read(a1 + 4 * PV));
                if (ML) { const f32x4 g0 = *(const LAS f32x4*)(gkv + 32 * ks + 8 * kg), g1 = *(const LAS f32x4*)(gkv + 32 * ks + 8 * kg + 4);
                    gkf[ks] = __builtin_bit_cast(bf16x8, (u32x4){cvt_pk_bf16(g0[0], g0[1]), cvt_pk_bf16(g0[2], g0[3]), cvt_pk_bf16(g1[0], g1[1]), cvt_pk_bf16(g1[2], g1[3])}); }
            }
            const bf16x8 ones = __builtin_bit_cast(bf16x8, (u32x4){0x3f803f80u, 0x3f803f80u, 0x3f803f80u, 0x3f803f80u});
            f32x4 O1[4], O2[4], O1n[ML ? 4 : 1], O2n[ML ? 4 : 1];
            {
                bf16x8 pa[4][2];
#pragma unroll
                for (int it = 0; it < 4; ++it)
#pragma unroll
                    for (int ks = 0; ks < 2; ++ks) pa[it][ks] = *(const LAS bf16x8*)(lds + O_PS + (16 * it + r16) * PP + (32 * ks + 8 * kg) * 2);
                u32x2 ql[2][4], qh[2][4];
                const LAS unsigned char* qa0 = lds + O_QS + r16 * PQ + (4 * kg) * 2;
#pragma unroll
                for (int it = 0; it < 4; ++it) { ql[0][it] = *(const LAS u32x2*)(qa0 + 16 * it * PQ); qh[0][it] = *(const LAS u32x2*)(qa0 + 16 * it * PQ + 32); }
                __builtin_amdgcn_sched_barrier(0);
#pragma unroll
                for (int it = 0; it < 4; ++it) { O1[it] = (f32x4){0.f, 0.f, 0.f, 0.f}; O2[it] = (f32x4){0.f, 0.f, 0.f, 0.f};
                    if (ML) { O1n[it] = (f32x4){0.f, 0.f, 0.f, 0.f}; O2n[it] = (f32x4){0.f, 0.f, 0.f, 0.f}; }
#pragma unroll
                    for (int ks = 0; ks < 2; ++ks) { O1[it] = __builtin_amdgcn_mfma_f32_16x16x32_bf16(pa[it][ks], bv[ks], O1[it], 0, 0, 0);
                        if (ML) O1n[it] = __builtin_amdgcn_mfma_f32_16x16x32_bf16(pa[it][ks], ones, O1n[it], 0, 0, 0); } }
#pragma unroll
                for (int m = 0; m < NKS; ++m) {
                    if (m + 1 < NKS) {
#pragma unroll
                        for (int it = 0; it < 4; ++it) { ql[(m + 1) & 1][it] = *(const LAS u32x2*)(qa0 + 16 * it * PQ + 64 * (m + 1)); qh[(m + 1) & 1][it] = *(const LAS u32x2*)(qa0 + 16 * it * PQ + 64 * (m + 1) + 32); } }
                    const f32x4 s0 = S[2 * m], s1 = S[2 * m + 1];
                    const bf16x8 sb = __builtin_bit_cast(bf16x8, (u32x4){cvt_pk_bf16(s0[0], s0[1]), cvt_pk_bf16(s0[2], s0[3]), cvt_pk_bf16(s1[0], s1[1]), cvt_pk_bf16(s1[2], s1[3])});
                    bf16x8 snb = sb;
                    if (ML) { const f32x4 n0 = Sn[2 * m], n1 = Sn[2 * m + 1];
                        snb = __builtin_bit_cast(bf16x8, (u32x4){cvt_pk_bf16(n0[0], n0[1]), cvt_pk_bf16(n0[2], n0[3]), cvt_pk_bf16(n1[0], n1[1]), cvt_pk_bf16(n1[2], n1[3])}); }
#pragma unroll
                    for (int it = 0; it < 4; ++it) { const bf16x8 a = __builtin_bit_cast(bf16x8, (u32x4){ql[m & 1][it].x, ql[m & 1][it].y, qh[m & 1][it].x, qh[m & 1][it].y});
                        O2[it] = __builtin_amdgcn_mfma_f32_16x16x32_bf16(a, sb, O2[it], 0, 0, 0);
                        if (ML) O2n[it] = __builtin_amdgcn_mfma_f32_16x16x32_bf16(a, snb, O2n[it], 0, 0, 0); }
                    __builtin_amdgcn_sched_barrier(0);
                }
            }
#pragma unroll
            for (int it = 0; it < 4; ++it) {
                const int i0 = 16 * it + 4 * kg; float o[4];
                if (!ML) {
#pragma unroll
                    for (int r = 0; r < 4; ++r) o[r] = O1[it][r] + __builtin_amdgcn_exp2f((float)(i0 + r + 1) * lg) * O2[it][r];
                } else {
                    const f32x4 wi = *(const LAS f32x4*)(winter + i0), en = *(const LAS f32x4*)(enm + i0);
#pragma unroll
                    for (int r = 0; r < 4; ++r) { const float den = O1n[it][r] + wi[r] * O2n[it][r];
                        o[r] = (O1[it][r] + wi[r] * O2[it][r]) / fmaxf(fabsf(den), en[r]); }
                }
#pragma unroll
                for (int r = 0; r < 4; ++r) *(LAS bf16_t*)(lds + O_OB + (i0 + r) * PV + (16 * w + r16) * 2) = (bf16_t)(cvt_pk_bf16(o[r], 0.f) & 0xffffu);
                __builtin_amdgcn_sched_barrier(0);
            }
            const float decay = ML ? gst : __builtin_amdgcn_exp2f(64.0f * lg);
            {
                bf16x8 ka[3][2];
                const LAS unsigned char* kt0 = lds + O_KS + (8 * kg + q4) * PQ + 8 * p4;
#pragma unroll
                for (int d0 = 0; d0 < 2; ++d0)
#pragma unroll
                    for (int ks = 0; ks < 2; ++ks) { const LAS unsigned char* ka_ = kt0 + 32 * ks * PQ + 32 * d0; ka[d0][ks] = cat4(tr_read(ka_), tr_read(ka_ + 4 * PQ)); }
#pragma unroll
                for (int dt = 0; dt < NDT; ++dt) {
                    if (dt + 2 < NDT) {
#pragma unroll
                        for (int ks = 0; ks < 2; ++ks) { const LAS unsigned char* ka_ = kt0 + 32 * ks * PQ + 32 * (dt + 2); ka[(dt + 2) % 3][ks] = cat4(tr_read(ka_), tr_read(ka_ + 4 * PQ)); } }
                    S[dt] = S[dt] * decay;
                    if (ML) Sn[dt] = Sn[dt] * decay;
#pragma unroll
                    for (int ks = 0; ks < 2; ++ks) { S[dt] = __builtin_amdgcn_mfma_f32_16x16x32_bf16(ka[dt % 3][ks], bvp[ks], S[dt], 0, 0, 0);
                        if (ML) Sn[dt] = __builtin_amdgcn_mfma_f32_16x16x32_bf16(ka[dt % 3][ks], gkf[ks], Sn[dt], 0, 0, 0); }
                    __builtin_amdgcn_sched_barrier(0);
                }
            }
        }
        BAR_LDS();
        asm volatile("" : "+v"(tv));
#pragma unroll
        for (int i = 0; i < 2; ++i) { const int id = tv + 512 * i, row = id >> 4, pc = id & 15;
            *(u32x4*)(outp + (row0 + c * 64 + row) * DM + ocol + pc * 8) = *(const LAS u32x4*)(lds + O_OB + row * PV + pc * 16); }
        if (c + 1 < NC) stage_chunk();
        BAR_LDS();
    }
}
#ifndef NAIVE_MIX
#define NAIVE_MIX 0
#endif
__device__ __forceinline__ void phase_mix(const Params& p, LAS unsigned char* lds, int bid, int nblk, int sel = 3, int qidx = 0) {
#if NAIVE_MIX
    if (bid < 32) retention_naive(p, lds, bid >> 2, bid & 3);
    else if (bid < 64) mlstm_naive(p, lds, (bid - 32) >> 2, (bid - 32) & 3);
#else
    if ((bid & 1) == 0 && bid < 256) { const int cid = bid >> 1;
        float* gscr = (float*)(p.ws + WS_BINTOK) + (size_t)cid * 32768;
        if (cid < 64) { if (sel & 1) chain_mfma<256, false>(p, lds, cid >> 3, (cid >> 1) & 3, cid & 1, gscr); }
        else { if (sel & 2) chain_mfma<128, true>(p, lds, (cid - 64) >> 3, ((cid - 64) >> 1) & 3, cid & 1, gscr); } }
#endif
    else if (sel == 3 && qidx == 0) {
        pg8::SchedDense S{T / 256, 4, nblk / 2, bid >> 1, (const char*)(p.ws + WS_WIN), DM * 2, INWM / 256 - 4}; pg8::EpiProj E{(bf16_t*)(p.ws + WS_RB)};
        pg8::gemm_phase<false, CFG_P2>(lds, (const char*)(p.ws + WS_U1B), DM * 2, S, E, p.ws + WS_DUMMY);
    }
    __syncthreads();
    expert_convert(p, lds, qidx);
}

__device__ __forceinline__ void phase_headnorm(const Params& p, LAS unsigned char* lds, int bid, int nblk) {
    const int tid = threadIdx.x, lane = tid & 63, wave = __builtin_amdgcn_readfirstlane(tid >> 6);
    const bf16_t* raw = (const bf16_t*)(p.ws + WS_RC); const bf16_t* proj = (const bf16_t*)(p.ws + WS_RB); bf16_t* mixed = (bf16_t*)(p.ws + WS_RA);
    LAS float* vnw = (LAS float*)lds;
    for (int i = tid; i < DM; i += NTHREADS) vnw[i] = (i < 1024) ? p.ret_norm_w[i] : p.ml_norm_w[i - 1024];
    __syncthreads();
    const int rpb = T / nblk;
    for (int r0 = bid * rpb + 2 * wave; r0 < (bid + 1) * rpb; r0 += 2 * NWAVES) {
        u32x4 rvq[2][4], gvq[2][4];
#pragma unroll
        for (int q2 = 0; q2 < 2; ++q2)
#pragma unroll
            for (int j = 0; j < 4; ++j) { const int col = 512 * j + 8 * lane; const int gcol = (j < 2) ? (PC_RG + col) : (PC_MO + col - 1024);
                rvq[q2][j] = __builtin_nontemporal_load((const u32x4*)(raw + (size_t)(r0 + q2) * DM + col)); gvq[q2][j] = __builtin_nontemporal_load((const u32x4*)(proj + (size_t)(r0 + q2) * INWM + gcol)); }
#pragma unroll
        for (int q2 = 0; q2 < 2; ++q2)
#pragma unroll
        for (int j = 0; j < 4; ++j) {
            const int r = r0 + q2;
            const int col = 512 * j + 8 * lane;
            const u32x4 rv = rvq[q2][j];
            const u32x4 gv = gvq[q2][j];
            const f32x4 w0 = *(const LAS f32x4*)(vnw + col), w1 = *(const LAS f32x4*)(vnw + col + 4);
            float x[8] = {bf_lo(rv.x), bf_hi(rv.x), bf_lo(rv.y), bf_hi(rv.y), bf_lo(rv.z), bf_hi(rv.z), bf_lo(rv.w), bf_hi(rv.w)};
            float gt[8] = {bf_lo(gv.x), bf_hi(gv.x), bf_lo(gv.y), bf_hi(gv.y), bf_lo(gv.z), bf_hi(gv.z), bf_lo(gv.w), bf_hi(gv.w)};
            float s = 0.f;
#pragma unroll
            for (int q = 0; q < 8; ++q) s += x[q];
            const float mean = half_sum(s) * (1.0f / 256.0f); float s2 = 0.f;
#pragma unroll
            for (int q = 0; q < 8; ++q) { x[q] -= mean; s2 += x[q] * x[q]; }
            const float rstd = 1.0f / sqrtf(half_sum(s2) * (1.0f / 256.0f) + GN_EPS);
            float o[8];
#pragma unroll
            for (int q = 0; q < 8; ++q) { const float wq = (q < 4) ? w0[q & 3] : w1[q & 3]; const float gg = (j < 2) ? fsilu(gt[q]) : fsigmoid(gt[q]); o[q] = x[q] * rstd * wq * gg; }
            *(u32x4*)(mixed + (size_t)r * DM + col) = (u32x4){cvt_pk_bf16(o[0], o[1]), cvt_pk_bf16(o[2], o[3]), cvt_pk_bf16(o[4], o[5]), cvt_pk_bf16(o[6], o[7])};
        }
    }
}

constexpr int PA = 4112;
constexpr int R_AHI = 0, R_ALO = 16 * PA, R_P = 32 * PA, R_LIST = R_P + 8192, R_LCNT = R_LIST + 4096, R_LBASE = R_LCNT + 256;
static_assert(R_LBASE + 256 <= BARW_OFF, "router LDS map");
__device__ __forceinline__ void phase_router(const Params& p, LAS unsigned char* lds, int bid, int nblk, int dry = 0) {
    const int tid = threadIdx.x, lane = tid & 63, wave = __builtin_amdgcn_readfirstlane(tid >> 6);
    unsigned char* ws = p.ws;
    const float* mod = (const float*)(ws + WS_MOD); const bf16_t* mix = (const bf16_t*)(ws + WS_RC);
    unsigned char* U8 = ws + WS_U2; float* wts = (float*)(ws + WS_WTS); unsigned* pos = (unsigned*)(ws + WS_POS);
    int* bin_tok = (int*)(ws + WS_BINTOK); unsigned* count = (unsigned*)(ws + WS_CTL) + CW_CNT + (dry ? 128 : 0);
    const bool do1 = !dry || (dry & 1), do2 = !dry || (dry & 2), do3 = !dry || (dry & 4);
    const bf16_t* WRH = (const bf16_t*)(ws + WS_WRHI); const bf16_t* WRL = (const bf16_t*)(ws + WS_WRLO);
    LAS float* P = (LAS float*)(lds + R_P);
    LAS unsigned* list = (LAS unsigned*)(lds + R_LIST);
    LAS unsigned* lcnt = (LAS unsigned*)(lds + R_LCNT); LAS unsigned* lbase = (LAS unsigned*)(lds + R_LBASE);
    const int tpb = T / nblk;
    const int tok0 = bid * tpb, b = tok0 / SEQ;
    if (tid < 64) lcnt[tid] = 0u;
    LAS float* vg1 = (LAS float*)(lds + R_ALO); LAS float* vlg = vg1 + DM; LAS float* vlb = vlg + DM; LAS float* vsc = vlb + DM; LAS float* vsh = vsc + DM;
    for (int i = tid; i < DM; i += NTHREADS) { vg1[i] = mod[b * MODW + 2 * DM + i]; vlg[i] = p.ln1_g[i]; vlb[i] = p.ln1_b[i]; vsc[i] = 1.0f + mod[b * MODW + 4 * DM + i]; vsh[i] = mod[b * MODW + 3 * DM + i]; }
    __syncthreads();
    const float ebias = p.e_bias[lane];
    for (int it = 0; it < tpb / 16; ++it) {
        if (do1)
#pragma unroll
        for (int q = 0; q < 2; ++q) {
            const int tl = 2 * wave + q, t = tok0 + it * 16 + tl;
            const f32x4* xr = (const f32x4*)(p.x + (size_t)t * DM) + lane; const u32x2* mr = (const u32x2*)(mix + (size_t)t * DM) + lane;
            f32x4 v[8]; float s = 0.f;
#pragma unroll
            for (int j = 0; j < 8; ++j) { const f32x4 xv = __builtin_nontemporal_load(xr + 64 * j); const u32x2 mv = __builtin_nontemporal_load(mr + 64 * j); const f32x4 g = *((const LAS f32x4*)vg1 + lane + 64 * j);
                v[j] = xv * DN_ALPHA + g * (f32x4){bf_lo(mv.x), bf_hi(mv.x), bf_lo(mv.y), bf_hi(mv.y)};
                s += (v[j][0] + v[j][1]) + (v[j][2] + v[j][3]); }
            const float mean = wave_sum(s) * (1.0f / DM); float s2 = 0.f;
#pragma unroll
            for (int j = 0; j < 8; ++j) { v[j] = v[j] - mean; s2 += (v[j][0] * v[j][0] + v[j][1] * v[j][1]) + (v[j][2] * v[j][2] + v[j][3] * v[j][3]); }
            const float rstd = 1.0f / sqrtf(wave_sum(s2) * (1.0f / DM) + LN_EPS);
            u32x2* orow = (u32x2*)(ws + WS_X1B + (size_t)t * DM * 2) + lane; unsigned* urow = (unsigned*)(U8 + (size_t)t * DM) + lane;
#pragma unroll
            for (int j = 0; j < 8; ++j) {
                const f32x4 lg = *((const LAS f32x4*)vlg + lane + 64 * j), lb = *((const LAS f32x4*)vlb + lane + 64 * j);
                const f32x4 x1 = v[j] * rstd * lg + lb;
                { const f32x4 xa = x1 * DN_ALPHA; orow[64 * j] = (u32x2){cvt_pk_bf16(xa[0], xa[1]), cvt_pk_bf16(xa[2], xa[3])}; }
                const f32x4 sc = *((const LAS f32x4*)vsc + lane + 64 * j), sh = *((const LAS f32x4*)vsh + lane + 64 * j);
                const f32x4 u = x1 * sc + sh;
                const unsigned h0 = cvt_pk_bf16(u[0], u[1]), h1 = cvt_pk_bf16(u[2], u[3]);
                { int d8 = 0; d8 = __builtin_amdgcn_cvt_pk_fp8_f32(u[0], u[1], d8, false); d8 = __builtin_amdgcn_cvt_pk_fp8_f32(u[2], u[3], d8, true); urow[64 * j] = (unsigned)d8; }
                *(LAS u32x2*)(lds + R_AHI + tl * PA + (4 * lane + 256 * j) * 2) = (u32x2){h0, h1};
            }
        }
        __syncthreads();
        if (do2) {
            const int nt = wave & 3, kh = wave >> 2, fr = lane & 15, fq = lane >> 4;
            f32x4 acc = (f32x4){0.f, 0.f, 0.f, 0.f}, acc2 = acc;
            const bf16_t* bh = WRH + ((size_t)((kh * 4 + nt) * 32) * 64 + lane) * 8; const bf16_t* bl = WRL + ((size_t)((kh * 4 + nt) * 32) * 64 + lane) * 8;
            const LAS unsigned char* ah = lds + R_AHI + fr * PA + (kh * 1024 + 8 * fq) * 2;
#pragma unroll 4
            for (int s = 0; s < 32; ++s) {
                const bf16x8 bhi = *(const bf16x8*)(bh + 512 * s);
                const bf16x8 ahi = *(const LAS bf16x8*)(ah + 64 * s);
                if (s & 1) acc2 = __builtin_amdgcn_mfma_f32_16x16x32_bf16(ahi, bhi, acc2, 0, 0, 0); else acc = __builtin_amdgcn_mfma_f32_16x16x32_bf16(ahi, bhi, acc, 0, 0, 0);
            }
#pragma unroll
            for (int r = 0; r < 4; ++r) P[(kh * 16 + 4 * fq + r) * 64 + 16 * nt + fr] = acc[r] + acc2[r];
        }
        __syncthreads();
        if (do3)
#pragma unroll
        for (int q = 0; q < 2; ++q) {
            const int tl = 2 * wave + q, tloc = it * 16 + tl, t = tok0 + tloc;
            const float logit = P[tl * 64 + lane] + P[(16 + tl) * 64 + lane];
            const float score = 1.0f / (1.0f + __expf(-logit));
            const float bs = score + ebias;
            const unsigned key = (__float_as_uint(bs + 1.0f) & ~63u) | (unsigned)(63 - lane);
            int rk = 0;
#pragma unroll
            for (int x = 1; x < 8; ++x) rk += (__shfl_xor(key, x) > key) ? 1 : 0;
            float gs = (rk < 2) ? bs : 0.f;
            gs += __shfl_xor(gs, 1); gs += __shfl_xor(gs, 2); gs += __shfl_xor(gs, 4);
            const unsigned gkey = (__float_as_uint(gs + 2.0f) & ~7u) | (unsigned)(7 - (lane >> 3));
            int grk = 0;
#pragma unroll
            for (int x = 1; x < 8; ++x) grk += (__shfl_xor(gkey, 8 * x) > gkey) ? 1 : 0;
            const unsigned mkey = (grk < 4) ? key : 0u;
            int erk = 0;
#pragma unroll
            for (int j = 0; j < 64; ++j) erk += ((unsigned)__builtin_amdgcn_readlane((int)mkey, j) > mkey) ? 1 : 0;
            const bool sel = erk < 8;
            const float wsum = wave_sum(sel ? score : 0.f);
            if (sel) {
                const unsigned lr = __hip_atomic_fetch_add(&lcnt[lane], 1u, __ATOMIC_RELAXED, __HIP_MEMORY_SCOPE_WORKGROUP);
                list[tloc * 8 + erk] = ((unsigned)lane << 16) | lr;
                wts[(size_t)t * 8 + erk] = score / wsum * 2.5f;
            }
        }
    }
    __syncthreads();
    if (!do3) return;
    if (tid < 64) lbase[tid] = __hip_atomic_fetch_add(count + tid, lcnt[tid], __ATOMIC_RELAXED, __HIP_MEMORY_SCOPE_AGENT);
    __syncthreads();
    for (int i = tid; i < tpb * 8; i += NTHREADS) { const unsigned v = list[i]; const unsigned e = v >> 16, slot = lbase[e] + (v & 0xffffu); const int t = tok0 + (i >> 3);
        bin_tok[e * 32768 + slot] = t; pos[(size_t)t * 8 + (i & 7)] = (e << 16) | slot; }
}

__device__ __forceinline__ void moe_tables(const Params& p, LAS unsigned char* lds, int& NRT) {
    LAS int* tstart = (LAS int*)(lds + TAB_OFF); LAS int* cstart = tstart + 128; LAS int* cnt = cstart + 128; LAS int* tile_e = cnt + 128;
    const unsigned* count = (const unsigned*)(p.ws + WS_CTL) + CW_CNT;
    const int tid = threadIdx.x;
    if (tid < 64) {
        const int c = (int)count[tid]; const int ntile = (c + 255) >> 8;
        int ps = ntile, pc = c;
#pragma unroll
        for (int o = 1; o < 64; o <<= 1) { const int a = __shfl_up(ps, o), b2 = __shfl_up(pc, o); if (tid >= o) { ps += a; pc += b2; } }
        tstart[tid] = ps - ntile; cstart[tid] = pc - c; cnt[tid] = c;
        if (tid == 63) { tstart[64] = ps; cstart[64] = pc; cnt[64] = T; tstart[65] = ps + T / 256; cstart[65] = pc + T; }
    }
    __syncthreads();
    NRT = tstart[65];
    for (int e = tid >> 3; e < 65; e += NTHREADS / 8) { const int t0 = tstart[e], t1 = tstart[e + 1]; for (int j = t0 + (tid & 7); j < t1; j += 8) tile_e[j] = e; }
    __syncthreads();
}

__device__ __forceinline__ void phase_final(const Params& p, LAS unsigned char* lds, int bid, int nblk, int dry = 0) {
    int tid = threadIdx.x; asm volatile("" : "+v"(tid));
    const int lane = tid & 63, wave = __builtin_amdgcn_readfirstlane(tid >> 6);
    int NRT; moe_tables(p, lds, NRT);
    LAS const int* tstart = (LAS const int*)(lds + TAB_OFF);
    const float* mod = (const float*)(p.ws + WS_MOD); const unsigned char* O = p.ws + WS_O;
    const unsigned* pos = (const unsigned*)(p.ws + WS_POS); const float* wts = (const float*)(p.ws + WS_WTS);
    const int tpb = T / nblk;
    LAS int* lcrow = (LAS int*)lds; LAS float* lw = (LAS float*)(lds + 8192);
    for (int i = tid; i < tpb * 8; i += NTHREADS) { const unsigned pv = pos[(size_t)bid * tpb * 8 + i]; lcrow[i] = 256 * tstart[pv >> 16] + (int)(pv & 0xffffu); lw[i] = wts[(size_t)bid * tpb * 8 + i] * 0.25f; }
    __syncthreads();
    for (int t = bid * tpb + wave; t < (bid + 1) * tpb; t += NWAVES) {
        const int b = t / SEQ; const float* g2 = mod + b * MODW + 5 * DM; const int tl8 = (t - bid * tpb) * 8;
        f32x4 a[8];
#pragma unroll
        for (int j = 0; j < 8; ++j) a[j] = (f32x4){0.f, 0.f, 0.f, 0.f};
#pragma unroll
        for (int k = 0; k < 9; ++k) {
            int crow; float w;
            if (k < 8) { crow = lcrow[tl8 + k]; w = lw[tl8 + k]; }
            else { crow = 256 * tstart[64] + t; w = 0.25f; }
            const unsigned* orow8 = (const unsigned*)(O + (size_t)crow * DM) + lane;
#pragma unroll
            for (int j = 0; j < 8; ++j) { const unsigned ov = __builtin_nontemporal_load(orow8 + 64 * j);
                const f32x2 e0 = __builtin_amdgcn_cvt_pk_f32_fp8((int)ov, false), e1 = __builtin_amdgcn_cvt_pk_f32_fp8((int)ov, true);
                a[j] += (f32x4){e0[0], e0[1], e1[0], e1[1]} * w; }
        }
        float* orow = (dry ? (float*)(p.ws + WS_RB) : p.out) + (size_t)t * DM;
        const u32x2* xrow = (const u32x2*)(p.ws + WS_X1B + (size_t)t * DM * 2) + lane;
        f32x4 v[8]; float s = 0.f;
#pragma unroll
        for (int j = 0; j < 8; ++j) { const f32x4 g = *((const f32x4*)g2 + lane + 64 * j); const u32x2 xb = __builtin_nontemporal_load(xrow + 64 * j); const f32x4 d = (f32x4){bf_lo(xb.x), bf_hi(xb.x), bf_lo(xb.y), bf_hi(xb.y)} + g * a[j];
            v[j] = d; s += (d[0] + d[1]) + (d[2] + d[3]); }
        asm volatile("" ::: "memory");
        const float mean = wave_sum(s) * (1.0f / DM); float s2 = 0.f;
#pragma unroll
        for (int j = 0; j < 8; ++j) { const f32x4 d = v[j] - mean; v[j] = d; s2 += (d[0] * d[0] + d[1] * d[1]) + (d[2] * d[2] + d[3] * d[3]); }
        const float rstd = 1.0f / sqrtf(wave_sum(s2) * (1.0f / DM) + LN_EPS);
#pragma unroll
        for (int j = 0; j < 8; ++j) { const f32x4 lg = *((const f32x4*)p.ln2_g + lane + 64 * j), lb = *((const f32x4*)p.ln2_b + lane + 64 * j);
            *((f32x4*)orow + lane + 64 * j) = v[j] * rstd * lg + lb; }
    }
}

__global__ void __launch_bounds__(NTHREADS, 2) mega(Params p) {
    extern __shared__ __attribute__((aligned(16))) unsigned char lds_raw[];
    LAS unsigned char* lds = (LAS unsigned char*)lds_raw;
    const int bid = blockIdx.x, nblk = gridDim.x, tid = threadIdx.x;
    volatile LAS unsigned* barw = (volatile LAS unsigned*)(lds + BARW_OFF);
    if (tid < 4) barw[tid] = 0u;
    __syncthreads();
    unsigned* ctl = (unsigned*)(p.ws + WS_CTL);
    const int lo = p.ph_lo, hi = p.ph_hi;
    XcdBarrier bar; bar.bar = ctl + CW_BAR; bar.x = 0; bar.st = barw;
    if (hi - lo > 1) bar = xcd_barrier_post(ctl + CW_BAR, barw);
#ifndef PH_MASK
#define PH_MASK 0x7FF
#endif
#define IN(k) (((PH_MASK >> (k)) & 1) && lo <= (k) && (k) < hi)
#define SEAM(k) do { if (IN(k) && IN((k) + 1)) xcd_barrier(bar); } while (0)
    unsigned char* ws = p.ws;
#ifndef DUP_MASK
#define DUP_MASK 0
#endif
#ifndef DRY_STEPS
#define DRY_STEPS 7
#endif
#ifndef DUP_SEL
#define DUP_SEL 3
#endif
#ifndef DUP_Q
#define DUP_Q 0
#endif
#define DUPK(k) (((DUP_MASK) >> (k)) & 1)
#define P2BODY { pg8::SchedDense S{T / 256, INWM / 256 - 4, nblk, bid, (const char*)(ws + WS_WIN), DM * 2, 0}; pg8::EpiProj E{(bf16_t*)(ws + WS_RB)}; pg8::gemm_phase<false, CFG_P2>(lds, (const char*)(ws + WS_RA), DM * 2, S, E, ws + WS_DUMMY); }
#define P5BODY { pg8::SchedDense S{T / 256, DM / 256, nblk, bid, (const char*)(ws + WS_WOUT), DM * 2, 0}; pg8::EpiPlain E{(bf16_t*)(ws + WS_RC), DM, 1.0f}; pg8::gemm_phase<false, CFG_P6>(lds, (const char*)(ws + WS_RA), DM * 2, S, E, ws + WS_DUMMY); }
#define P7BODY { int NRT; moe_tables(p, lds, NRT); \
        pg8::SchedMoE S{tab, tab + 128, tab + 256, tab + 384, NRT, 4, 0, nblk, bid, (const char*)(ws + WS_WGU), (size_t)1024 * DM, DM, 1, (const int*)(ws + WS_BINTOK)}; \
        pg8::EpiSwiGLU8 E{ws + WS_H}; pg8::gemm_phase<true, CFG_P8>(lds, (const char*)(ws + WS_U2), DM, S, E, ws + WS_DUMMY); }
#define P8BODY(pnoff) { int NRT; moe_tables(p, lds, NRT); \
        pg8::SchedMoE S{tab, tab + 128, tab + 256, tab + 384, NRT, 8, pnoff, nblk, bid, (const char*)(ws + WS_WD), (size_t)DM * FE, FE, 0, nullptr}; \
        pg8::EpiPlain8 E{ws + WS_O, DM, 0.0625f}; pg8::gemm_phase<true, CFG_P9>(lds, (const char*)(ws + WS_H), FE, S, E, ws + WS_DUMMY); }
    LAS const int* tab = (LAS const int*)(lds + TAB_OFF);
    if (IN(0)) { phase_prologue(p, lds, bid, nblk); if (DUPK(0)) { __syncthreads(); phase_prologue(p, lds, bid, nblk); } } SEAM(0);
    if (IN(1)) { phase_modulate(p, lds, bid, nblk); if (DUPK(1)) { __syncthreads(); phase_modulate(p, lds, bid, nblk); } } SEAM(1);
    if (IN(2)) { P2BODY if (DUPK(2)) P2BODY } SEAM(2);
    if (IN(3)) { phase_conv(p, lds, bid, nblk); } SEAM(3);
    if (IN(4)) { phase_mix(p, lds, bid, nblk); if (DUPK(4)) { __syncthreads(); phase_mix(p, lds, bid, nblk, DUP_SEL, DUP_Q); } } SEAM(4);
    if (IN(5)) { phase_headnorm(p, lds, bid, nblk); if (DUPK(5)) phase_headnorm(p, lds, bid, nblk); } SEAM(5);
    if (IN(6)) { P5BODY if (DUPK(6)) P5BODY } SEAM(6);
    if (IN(7)) { if (DUPK(7)) { phase_router(p, lds, bid, nblk, DRY_STEPS); __syncthreads(); } phase_router(p, lds, bid, nblk); } SEAM(7);
    if (IN(8)) { P7BODY if (DUPK(8)) P7BODY } SEAM(8);
    if (IN(9)) { P8BODY(0) if (DUPK(9)) P8BODY(0) } SEAM(9);
    if (IN(10)) { for (int rep_ = DUPK(10) ? 1 : 0; rep_ >= 0; --rep_) { phase_final(p, lds, bid, nblk, rep_); __syncthreads(); } }
#undef IN
#undef SEAM
}

constexpr int NPHASES = 11;
extern "C" void kernel_launch(void* const* d_in, const int* in_sizes, int n_in, void* d_out, int out_size, void* d_ws, size_t ws_size, hipStream_t stream) {
    static int grid = 0;
    if (grid == 0) {
        if (n_in != 23 || in_sizes[0] != T * DM || out_size != T * DM || ws_size < WS_END) { fprintf(stderr, "kernel_launch: unexpected shapes / workspace (%d inputs, ws %zu, need %zu)\n", n_in, ws_size, (size_t)WS_END); grid = -1; return; }
        if (hipFuncSetAttribute((const void*)mega, hipFuncAttributeMaxDynamicSharedMemorySize, LDS_BYTES) != hipSuccess) { fprintf(stderr, "kernel_launch: hipFuncSetAttribute failed\n"); grid = -1; return; }
        int dev = 0, cus = 0, per_cu = 0;
        hipGetDevice(&dev); hipDeviceGetAttribute(&cus, hipDeviceAttributeMultiprocessorCount, dev);
        if (hipOccupancyMaxActiveBlocksPerMultiprocessor(&per_cu, (const void*)mega, NTHREADS, LDS_BYTES) != hipSuccess || per_cu < 1) fprintf(stderr, "kernel_launch: occupancy query says %d\n", per_cu);
        (void)hipGetLastError();
        grid = 256;
        if (cus != 256) fprintf(stderr, "kernel_launch: device has %d CUs; this kernel is built for a resident grid of 256 workgroups\n", cus);
    }
    if (grid < 0) return;
    hipMemsetAsync((char*)d_ws + WS_CTL, 0, CTL_BYTES, stream);
    Params p{};
    const float** f = (const float**)&p;
    for (int i = 0; i < 23; ++i) f[i] = (const float*)d_in[i];
    p.out = (float*)d_out; p.ws = (unsigned char*)d_ws;
#ifndef N_LAUNCHES
#define N_LAUNCHES 1
#endif
    if (N_LAUNCHES == 1) { p.ph_lo = 0; p.ph_hi = NPHASES; hipLaunchKernelGGL(mega, dim3(grid), dim3(NTHREADS), LDS_BYTES, stream, p); }
    else for (int ph = 0; ph < NPHASES; ++ph) {
        p.ph_lo = ph; p.ph_hi = ph + 1;
        hipLaunchKernelGGL(mega, dim3(grid), dim3(NTHREADS), LDS_BYTES, stream, p);
    }
}
```

```cpp
#include <hip/hip_runtime.h>
#include <cstdio>
#include <cstdint>

#define LAS __attribute__((address_space(3)))
typedef unsigned short bf16_t;
typedef short bf16x8 __attribute__((ext_vector_type(8)));
typedef float f32x4 __attribute__((ext_vector_type(4)));
typedef float f32x2 __attribute__((ext_vector_type(2)));
typedef unsigned u32x4 __attribute__((ext_vector_type(4)));
typedef unsigned u32x2 __attribute__((ext_vector_type(2)));
typedef int i32x4 __attribute__((ext_vector_type(4)));
typedef int i32x8 __attribute__((ext_vector_type(8)));

constexpr int DM = 2048, NBATCH = 8, SEQ = 4096, T = NBATCH * SEQ;
constexpr int INW = 7176, INWM = 7168;
constexpr int NE = 64, FE = 512;
constexpr int MODW = 6 * DM;
constexpr float DN_ALPHA = 1.189207115002721f;
constexpr float LN_EPS = 1e-5f, GN_EPS = 1e-6f;
constexpr int NTHREADS = 512, NWAVES = 8;
constexpr int PC_RQ = 0, PC_RK = 1024, PC_RV = 2048, PC_RG = 3072, PC_MQK = 4096, PC_MV = 5120, PC_MO = 6144;

constexpr size_t MiB = 1u << 20;
constexpr size_t WS_CTL = 0, CTL_BYTES = 1 * MiB;
constexpr size_t WS_MOD = 1 * MiB;
constexpr size_t WS_GATEW = 1 * MiB + 512 * 1024;
constexpr size_t WS_GATES = 2 * MiB;
constexpr size_t WS_WRHI = 3 * MiB, WS_WRLO = 3 * MiB + 256 * 1024;
constexpr size_t WS_POS = 4 * MiB;
constexpr size_t WS_WTS = 5 * MiB;
constexpr size_t WS_BINTOK = 8 * MiB;
constexpr size_t WS_WIN = 24 * MiB;
constexpr size_t WS_WOUT = 52 * MiB;
constexpr size_t WS_WD = 60 * MiB;
constexpr size_t WS_WGU = 190 * MiB;
constexpr size_t WS_RA = 450 * MiB;
constexpr size_t WS_U1B = WS_RA;
constexpr size_t WS_CONV = 320 * MiB;
constexpr size_t WS_RC = 578 * MiB;
constexpr size_t WS_RB = 706 * MiB;
constexpr size_t WS_U2 = WS_RB, WS_H = WS_RB + 128 * MiB;
constexpr size_t WS_O = 190 * MiB;
constexpr size_t WS_X1B = 990 * MiB;
constexpr size_t WS_DUMMY = 1118 * MiB;
constexpr size_t WS_END = 1154 * MiB;
static_assert(WS_O + (size_t)311296 * 1024 * 2 <= WS_H, "o overlay");
static_assert(WS_H + (size_t)311296 * 1024 <= WS_END, "h");
constexpr int CW_BAR = 4096, CW_CNT = 8192, CW_QUEUE = 8192 + 256;

constexpr int RING_BYTES = 131072;
constexpr int TAB_OFF = 131072;
constexpr int LDS_BYTES = 147456;
constexpr int BARW_OFF = LDS_BYTES - 64;

struct Params {
    const float *x, *c, *w_ada, *b_ada, *w_in, *b_gates, *conv_w, *conv_b, *ret_norm_w, *ml_norm_w, *w_out, *ln1_g, *ln1_b,
                *w_router, *e_bias, *w_gate, *w_up, *w_down, *ws_gate, *ws_up, *ws_down, *ln2_g, *ln2_b;
    float* out; unsigned char* ws; int ph_lo, ph_hi;
};

__device__ __forceinline__ unsigned cvt_pk_bf16(float lo, float hi) { unsigned r; asm("v_cvt_pk_bf16_f32 %0, %1, %2" : "=v"(r) : "v"(lo), "v"(hi)); return r; }
__device__ __forceinline__ float bf_lo(unsigned w) { return __uint_as_float(w << 16); }
__device__ __forceinline__ float bf_hi(unsigned w) { return __uint_as_float(w & 0xffff0000u); }
__device__ __forceinline__ float bf2f(bf16_t b) { return __uint_as_float(((unsigned)b) << 16); }
#define DPPF(v, ctrl) __builtin_bit_cast(float, __builtin_amdgcn_update_dpp(0, __builtin_bit_cast(int, (v)), (ctrl), 0xF, 0xF, true))
__device__ __forceinline__ float row_sum16(float v) {
    v += DPPF(v, 0xB1);
    v += DPPF(v, 0x4E);
    v += DPPF(v, 0x141);
    v += DPPF(v, 0x140);
    return v;
}
__device__ __forceinline__ float rl(float v, int l) { return __builtin_bit_cast(float, __builtin_amdgcn_readlane(__builtin_bit_cast(int, v), l)); }
__device__ __forceinline__ float wave_sum(float v) { const float r = row_sum16(v); return (rl(r, 0) + rl(r, 16)) + (rl(r, 32) + rl(r, 48)); }
__device__ __forceinline__ float half_sum(float v) {
    const float r = row_sum16(v); const float lo = rl(r, 0) + rl(r, 16), hi = rl(r, 32) + rl(r, 48);
    return (threadIdx.x & 32) ? hi : lo;
}
__device__ __forceinline__ float fsilu(float x) { return x * __builtin_amdgcn_rcpf(1.0f + __builtin_amdgcn_exp2f(-1.4426950408889634f * x)); }
__device__ __forceinline__ float fsigmoid(float x) { return __builtin_amdgcn_rcpf(1.0f + __builtin_amdgcn_exp2f(-1.4426950408889634f * x)); }
#define LDS_WAIT() asm volatile("s_waitcnt lgkmcnt(0)" ::: "memory")

#define XB_TMO      128
#define XB_XCNT(j)  (256  + 64 * (j))
#define XB_XSUB(j)  (1280 + 64 * (j))
#define XB_XGEN(j)  (2304 + 64 * (j))
#define XB_TOP      3328
#define XB_TOPGEN   3392
#define XCD_BAR_WORDS 3456
#define XB_SPIN_CAP (1u << 18)
__device__ __forceinline__ unsigned xb_ld(unsigned* p)              { return __hip_atomic_load(p, __ATOMIC_RELAXED, __HIP_MEMORY_SCOPE_AGENT); }
__device__ __forceinline__ unsigned xb_add(unsigned* p, unsigned v) { return __hip_atomic_fetch_add(p, v, __ATOMIC_RELAXED, __HIP_MEMORY_SCOPE_AGENT); }
__device__ __forceinline__ unsigned xb_xcc_id() { return (unsigned)__builtin_amdgcn_s_getreg((3 << 11) | 20) & 0xFu; }
#define XB_SPIN(cond, bar) do { unsigned _sp = 0; while (cond) { __builtin_amdgcn_s_sleep(1); \
    if ((++_sp & 255u) == 0u) { if (xb_ld(&(bar)[XB_TMO])) break; if (_sp > XB_SPIN_CAP) { atomicAdd(&(bar)[XB_TMO], 1u); break; } } } } while (0)
struct XcdBarrier { unsigned* bar; unsigned x; volatile LAS unsigned* st; };
__device__ __forceinline__ XcdBarrier xcd_barrier_post(unsigned* bar, volatile LAS unsigned* st) {
    XcdBarrier b; b.bar = bar; b.x = xb_xcc_id(); b.st = st;
    if (threadIdx.x == 0) (void)xb_add(&bar[XB_XCNT(b.x)], 1u);
    return b;
}
__device__ __forceinline__ void xcd_barrier_complete(unsigned* bar, unsigned x, unsigned& nloc, unsigned& nx) {
    const unsigned G = gridDim.x * gridDim.y * gridDim.z;
    unsigned sum, cnt, mine, sp = 0u;
    for (;;) {
        sum = 0u; cnt = 0u; mine = 0u;
#pragma unroll
        for (unsigned j = 0; j < 16; ++j) { const unsigned c = xb_ld(&bar[XB_XCNT(j)]); sum += c; cnt += (c > 0u) ? 1u : 0u; mine = (j == x) ? c : mine; }
        if (sum == G) break;
        __builtin_amdgcn_s_sleep(1);
        if ((++sp & 255u) == 0u) { if (xb_ld(&bar[XB_TMO])) break; if (sp > XB_SPIN_CAP) { atomicAdd(&bar[XB_TMO], 1u); break; } }
    }
    nloc = mine > 0u ? mine : 1u; nx = cnt > 0u ? cnt : 1u;
}
__device__ __forceinline__ void xcd_barrier(const XcdBarrier& b) {
    asm volatile("s_waitcnt vmcnt(0)" ::: "memory");
    __syncthreads();
    if (threadIdx.x == 0) {
        unsigned* bar = b.bar;
        __builtin_amdgcn_s_waitcnt(0);
        unsigned nloc = b.st[0], nx = b.st[1];
        if (nloc == 0u) { xcd_barrier_complete(bar, b.x, nloc, nx); b.st[0] = nloc; b.st[1] = nx; }
        const unsigned old = xb_add(&bar[XB_XSUB(b.x)], 1u);
        const unsigned gen = old / nloc;
        if (old + 1u == (gen + 1u) * nloc) {
            __builtin_amdgcn_fence(__ATOMIC_RELEASE, "agent");
            asm volatile("s_waitcnt vmcnt(0)" ::: "memory");
            const unsigned og = xb_add(&bar[XB_TOP], 1u);
            const unsigned tg = og / nx;
            if (og + 1u == (tg + 1u) * nx) xb_add(&bar[XB_TOPGEN], 1u);
            else XB_SPIN(xb_ld(&bar[XB_TOPGEN]) == tg, bar);
            __builtin_amdgcn_fence(__ATOMIC_ACQUIRE, "agent");
            xb_add(&bar[XB_XGEN(b.x)], 1u);
            asm volatile("s_waitcnt vmcnt(0)" ::: "memory");
        } else {
            XB_SPIN(xb_ld(&bar[XB_XGEN(b.x)]) == gen, bar);
            __builtin_amdgcn_fence(__ATOMIC_ACQUIRE, "agent");
            asm volatile("s_waitcnt vmcnt(0)" ::: "memory");
        }
    }
    __syncthreads();
}

namespace pg8 {
constexpr int BM = 256, BK = 64, HALF = 128, HTB = HALF * BK * 2, STAGE_BYTES = 8 * HTB, NXCD = 8, WGM = 8;
__host__ __device__ __forceinline__ int lds_byte(int r, int c) { const int st = (r >> 4) * 2 + (c >> 5), rr = r & 15, cc = c & 31, ob = rr * 64 + cc * 2; return st * 1024 + (ob ^ (((ob >> 9) & 1) << 5)); }
__host__ __device__ __forceinline__ void stage_rc(int b, int& R, int& C) { const int st = b / 1024, sb = b % 1024, swz = sb ^ (((sb >> 9) & 1) << 5); R = (st >> 1) * 16 + swz / 64; C = (st & 1) * 32 + (swz % 64) / 2; }
__host__ __device__ __forceinline__ int perm32(int rho) { const int n = rho >> 4, i = rho & 15, fq = i >> 2; return 16 * (fq & 1) + 8 * (fq >> 1) + 4 * n + (i & 3); }

struct Unit { int pm, pn; const char* B; int e, r0, cnt, crow0; };

__device__ __forceinline__ bool order_next(int i, int G, int c, int nM, int nN, int& pm, int& pn) {
    const int nwg = nM * nN; const long L = (long)i * G + c; if (L >= nwg) return false;
    int wgid = (int)L; { const int q = nwg / NXCD, r = nwg % NXCD, xcd = wgid % NXCD, off = wgid / NXCD; wgid = (xcd < r ? xcd * (q + 1) : r * (q + 1) + (xcd - r) * q) + off; }
    const int nig = WGM * nN, gid = wgid / nig, fm = gid * WGM, gsz = (nM - fm) < WGM ? (nM - fm) : WGM;
    pm = fm + ((wgid % nig) % gsz); pn = (wgid % nig) / gsz; return true;
}

struct SchedDense {
    int nM, nN, G, c; const char* Bt; int KB; int pn_off;
    __device__ __forceinline__ bool next(int i, Unit& u) const {
        if (!order_next(i, G, c, nM, nN, u.pm, u.pn)) return false;
        u.pn += pn_off; u.B = Bt + (size_t)u.pn * 256 * KB; u.e = 0; u.r0 = 0; u.cnt = 0; u.crow0 = 0; return true;
    }
    __device__ __forceinline__ void a_rows(const Unit& u, const int (&Rp)[2], int (&ix)[2][2]) const {
#pragma unroll
        for (int h = 0; h < 2; ++h)
#pragma unroll
            for (int i = 0; i < 2; ++i) ix[h][i] = u.pm * 256 + h * 128 + Rp[i];
    }
};
struct SchedMoE {
    LAS const int* tstart; LAS const int* cstart; LAS const int* cnt; LAS const int* tile_e;
    int NRT, nN, pn_off, G, c; const char* W; size_t wstride; int KB; int gather; const int* bin_tok;
    __device__ __forceinline__ bool next(int i, Unit& u) const {
        if (!order_next(i, G, c, NRT, nN, u.pm, u.pn)) return false;
        const int e = tile_e[u.pm]; const int j = u.pm - tstart[e];
        u.e = e; u.r0 = 256 * j; u.cnt = cnt[e]; u.crow0 = cstart[e] + 256 * j;
        u.B = W + (size_t)e * wstride + (size_t)(u.pn + pn_off) * 256 * KB; return true;
    }
    __device__ __forceinline__ void a_rows(const Unit& u, const int (&Rp)[2], int (&ix)[2][2]) const {
#pragma unroll
        for (int h = 0; h < 2; ++h)
#pragma unroll
            for (int i = 0; i < 2; ++i) {
                if (gather) { const int slot = u.r0 + h * 128 + Rp[i]; int tok = slot;
                    if (u.e < NE) tok = (slot < u.cnt) ? bin_tok[u.e * 32768 + slot] : 0;
                    ix[h][i] = tok; }
                else ix[h][i] = u.pm * 256 + h * 128 + Rp[i];
            }
    }
};

struct EpiPlain { static constexpr int PERM = 2; static constexpr int NSTORE = 16; bf16_t* O; int ldc; float sc;
    __device__ __forceinline__ void operator()(const f32x4 (&acc)[2][2][4][2], const Unit& u, int wr, int wc, int fr, int fq) const {
        const int row0 = u.pm * BM + wr * 64 + fr, col0 = u.pn * BM + wc * 64 + 16 * fq;
#pragma unroll
        for (int ai = 0; ai < 2; ++ai)
#pragma unroll
            for (int m = 0; m < 4; ++m) { bf16_t* rowp = O + (size_t)(row0 + ai * HALF + m * 16) * ldc + col0;
#pragma unroll
                for (int bj = 0; bj < 2; ++bj) { const f32x4 v0 = acc[ai][bj][m][0] * sc, v1 = acc[ai][bj][m][1] * sc;
                    u32x4 w; w.x = cvt_pk_bf16(v0[0], v0[1]); w.y = cvt_pk_bf16(v0[2], v0[3]); w.z = cvt_pk_bf16(v1[0], v1[1]); w.w = cvt_pk_bf16(v1[2], v1[3]);
                    *(u32x4*)(rowp + bj * 8) = w; } }
    }
};
struct EpiPlain8 { static constexpr int PERM = 2; static constexpr int NSTORE = 8; unsigned char* O; int ldc; float sc;
    __device__ __forceinline__ void operator()(const f32x4 (&acc)[2][2][4][2], const Unit& u, int wr, int wc, int fr, int fq) const {
        const int row0 = u.pm * BM + wr * 64 + fr, col0 = u.pn * BM + wc * 64 + 16 * fq;
#pragma unroll
        for (int ai = 0; ai < 2; ++ai)
#pragma unroll
            for (int m = 0; m < 4; ++m) { unsigned char* rowp = O + (size_t)(row0 + ai * HALF + m * 16) * ldc + col0; int d[4] = {0, 0, 0, 0};
#pragma unroll
                for (int bj = 0; bj < 2; ++bj) { const f32x4 v0 = acc[ai][bj][m][0] * sc, v1 = acc[ai][bj][m][1] * sc;
                    d[2 * bj] = __builtin_amdgcn_cvt_pk_fp8_f32(v0[0], v0[1], d[2 * bj], false); d[2 * bj] = __builtin_amdgcn_cvt_pk_fp8_f32(v0[2], v0[3], d[2 * bj], true);
                    d[2 * bj + 1] = __builtin_amdgcn_cvt_pk_fp8_f32(v1[0], v1[1], d[2 * bj + 1], false); d[2 * bj + 1] = __builtin_amdgcn_cvt_pk_fp8_f32(v1[2], v1[3], d[2 * bj + 1], true); }
                *(u32x4*)rowp = (u32x4){(unsigned)d[0], (unsigned)d[1], (unsigned)d[2], (unsigned)d[3]}; }
    }
};
struct EpiProj { static constexpr int PERM = 2; static constexpr int NSTORE = 16; bf16_t* O;
    __device__ __forceinline__ void operator()(const f32x4 (&acc)[2][2][4][2], const Unit& u, int wr, int wc, int fr, int fq) const {
        const int row0 = u.pm * BM + wr * 64 + fr, col0 = u.pn * BM + wc * 64 + 16 * fq;
        const bool rot = u.pn < 8; const float ks = (u.pn >= 4 && u.pn < 8) ? 0.0625f : 1.0f;
        float inv[2][2][2];
#pragma unroll
        for (int bj = 0; bj < 2; ++bj)
#pragma unroll
            for (int n = 0; n < 2; ++n)
#pragma unroll
                for (int q = 0; q < 2; ++q) { const int d = 64 * wc + 16 * fq + 8 * bj + 4 * n + 2 * q; inv[bj][n][q] = __builtin_amdgcn_exp2f(-(float)(d >> 1) * 0.10381025296523008f) * 0.15915494309189535f; }
#pragma unroll
        for (int ai = 0; ai < 2; ++ai)
#pragma unroll
            for (int m = 0; m < 4; ++m) { const int row = row0 + ai * HALF + m * 16; const float fs = (float)(row & (SEQ - 1)); bf16_t* rowp = O + (size_t)row * INWM + col0;
#pragma unroll
                for (int bj = 0; bj < 2; ++bj) { f32x4 v[2] = {acc[ai][bj][m][0], acc[ai][bj][m][1]};
                    if (rot) {
#pragma unroll
                        for (int n = 0; n < 2; ++n)
#pragma unroll
                            for (int q = 0; q < 2; ++q) { float t = fs * inv[bj][n][q]; t = t - floorf(t);
                                const float sn = __builtin_amdgcn_sinf(t), cs = __builtin_amdgcn_cosf(t); const float a = v[n][2 * q], b = v[n][2 * q + 1];
                                v[n][2 * q] = (a * cs - b * sn) * ks; v[n][2 * q + 1] = (a * sn + b * cs) * ks; } }
                    u32x4 w; w.x = cvt_pk_bf16(v[0][0], v[0][1]); w.y = cvt_pk_bf16(v[0][2], v[0][3]); w.z = cvt_pk_bf16(v[1][0], v[1][1]); w.w = cvt_pk_bf16(v[1][2], v[1][3]);
                    *(u32x4*)(rowp + bj * 8) = w; } }
    }
};
struct EpiSwiGLU8 { static constexpr int PERM = 1; static constexpr int NSTORE = 4; unsigned char* H;
    __device__ __forceinline__ void operator()(const f32x4 (&acc)[2][2][4][2], const Unit& u, int wr, int wc, int fr, int fq) const {
        const int row0 = u.pm * BM + wr * 64 + fr + ((fq >> 1) ? 16 : 0), col0 = u.pn * HALF + wc * 32 + 16 * (fq & 1);
#pragma unroll
        for (int ai = 0; ai < 2; ++ai)
#pragma unroll
            for (int mp = 0; mp < 2; ++mp) {
                unsigned d[2][2];
#pragma unroll
                for (int q = 0; q < 2; ++q) { const int m = 2 * mp + q; float hv[8];
#pragma unroll
                    for (int n = 0; n < 2; ++n)
#pragma unroll
                        for (int j = 0; j < 4; ++j) hv[4 * n + j] = fsilu(acc[ai][0][m][n][j] * 0.015625f) * (acc[ai][1][m][n][j] * 0.015625f);
                    int d0 = 0, d1 = 0;
                    d0 = __builtin_amdgcn_cvt_pk_fp8_f32(hv[0], hv[1], d0, false); d0 = __builtin_amdgcn_cvt_pk_fp8_f32(hv[2], hv[3], d0, true);
                    d1 = __builtin_amdgcn_cvt_pk_fp8_f32(hv[4], hv[5], d1, false); d1 = __builtin_amdgcn_cvt_pk_fp8_f32(hv[6], hv[7], d1, true);
                    d[q][0] = (unsigned)d0; d[q][1] = (unsigned)d1; }
                const auto s0 = __builtin_amdgcn_permlane32_swap(d[0][0], d[1][0], false, false);
                const auto s1 = __builtin_amdgcn_permlane32_swap(d[0][1], d[1][1], false, false);
                *(u32x4*)(H + (size_t)(row0 + ai * HALF + mp * 32) * FE + col0) = (u32x4){s0[0], s1[0], s0[1], s1[1]};
            }
    }
};

#define CFG_P2 true, true
#define CFG_P6 true, true
#define CFG_P8 true, true
#define CFG_P9 true, true
template <bool FP8, bool SP2, bool ALIGN_EPI, class Epi, class Sched>
__device__ __forceinline__ void gemm_phase(LAS unsigned char* lds, const char* Abase, const int KB, const Sched& S, const Epi& E, void* dummy) {
    const int tid = threadIdx.x, wid = __builtin_amdgcn_readfirstlane(tid >> 6), lane = tid & 63, wr = wid >> 2, wc = wid & 3, fr = lane & 15, fq = lane >> 4;
    const int nt = KB / (BK * 2);
    int Rp[2]; unsigned cb[2], voffB[2][2];
#pragma unroll
    for (int i = 0; i < 2; ++i) { int R, C; stage_rc(tid * 16 + i * 8192, R, C); Rp[i] = R; cb[i] = (unsigned)C * 2u;
#pragma unroll
        for (int h = 0; h < 2; ++h) { const int Rb = (Epi::PERM == 2) ? (64 * (R >> 5) + 16 * ((R & 15) >> 2) + 8 * h + 4 * ((R >> 4) & 1) + (R & 3)) : (128 * h + (R & ~31) + perm32(R & 31));
            voffB[h][i] = (unsigned)(Rb * KB + C * 2); } }
    const unsigned rowb = (unsigned)KB;
    const size_t kstep = (size_t)(BK * 2);
    const size_t hstep = (size_t)HALF * KB;
    const unsigned ldsw = (unsigned)wid * 1024u;
    const int aoff = FP8 ? lds_byte(wr * 64 + fr, 16 * fq) : lds_byte(wr * 64 + fr, fq * 8), boff = FP8 ? lds_byte(wc * 32 + fr, 16 * fq) : lds_byte(wc * 32 + fr, fq * 8);
    constexpr int KOFF = FP8 ? 16 : 1024;
#define PG8_SA(b, h) (((b) * 2 + (h)) * HTB)
#define PG8_SB(b, h) ((4 + (b) * 2 + (h)) * HTB)
#define PG8_STAGEA(bufoff, kb, av) do { _Pragma("unroll") for (int _i = 0; _i < 2; ++_i) \
        __builtin_amdgcn_global_load_lds((const unsigned*)(Abase + (kb) + (av)[_i]), (LAS unsigned*)(lds + (bufoff) + ldsw + _i * 8192), 16, 0, 0); } while (0)
#define PG8_STAGEB(bufoff, gbase, h) do { _Pragma("unroll") for (int _i = 0; _i < 2; ++_i) \
        __builtin_amdgcn_global_load_lds((const unsigned*)((const char*)(gbase) + voffB[h][_i]), (LAS unsigned*)(lds + (bufoff) + ldsw + _i * 8192), 16, 0, 0); } while (0)
#define PG8_LDA(dst, b, h) do { _Pragma("unroll") for (int m = 0; m < 4; ++m) _Pragma("unroll") for (int k = 0; k < 2; ++k) dst[m][k] = *(const LAS bf16x8*)(lds + PG8_SA(b, h) + aoff + m * 2048 + k * KOFF); } while (0)
#define PG8_LDB(dst, b, h) do { _Pragma("unroll") for (int n = 0; n < 2; ++n) _Pragma("unroll") for (int k = 0; k < 2; ++k) dst[n][k] = *(const LAS bf16x8*)(lds + PG8_SB(b, h) + boff + n * 2048 + k * KOFF); } while (0)
#define PG8_CAT8(x) __builtin_shufflevector(__builtin_bit_cast(i32x4, (x)[0]), __builtin_bit_cast(i32x4, (x)[1]), 0, 1, 2, 3, 4, 5, 6, 7)
#define PG8_MMA(ai, bj, At, Bt) do { __builtin_amdgcn_s_setprio(1); _Pragma("unroll") for (int m = 0; m < 4; ++m) _Pragma("unroll") for (int n = 0; n < 2; ++n) { \
        if constexpr (FP8) { const i32x8 a8_ = PG8_CAT8(Bt[n]), b8_ = PG8_CAT8(At[m]); asm volatile("v_mfma_f32_16x16x128_f8f6f4 %0, %1, %2, %0" : "+v"(acc[ai][bj][m][n]) : "v"(a8_), "v"(b8_)); } \
        else { _Pragma("unroll") for (int k = 0; k < 2; ++k) acc[ai][bj][m][n] = __builtin_amdgcn_mfma_f32_16x16x32_bf16(Bt[n][k], At[m][k], acc[ai][bj][m][n], 0, 0, 0); } } \
        __builtin_amdgcn_s_setprio(0); } while (0)
#define PG8_MMA0(ai, bj, At, Bt) do { __builtin_amdgcn_s_setprio(1); _Pragma("unroll") for (int m = 0; m < 4; ++m) _Pragma("unroll") for (int n = 0; n < 2; ++n) { \
        const i32x8 a8_ = PG8_CAT8(Bt[n]), b8_ = PG8_CAT8(At[m]); asm volatile("v_mfma_f32_16x16x128_f8f6f4 %0, %1, %2, 0" : "=&v"(acc[ai][bj][m][n]) : "v"(a8_), "v"(b8_)); } \
        __builtin_amdgcn_s_setprio(0); } while (0)
#define PG8_WAIT_V(n) asm volatile("s_waitcnt vmcnt(" #n ")" ::: "memory")
#define PG8_WAIT_L(n) asm volatile("s_waitcnt lgkmcnt(" #n ")" ::: "memory")
#define PG8_WAIT_VR do { if constexpr (Epi::NSTORE == 16) PG8_WAIT_V(24); else if constexpr (Epi::NSTORE == 8) PG8_WAIT_V(16); else { static_assert(Epi::NSTORE == 4 || Epi::NSTORE == 8 || Epi::NSTORE == 16, "NSTORE"); PG8_WAIT_V(12); } } while (0)
#define PG8_BAR __builtin_amdgcn_s_barrier()
#define PG8_SCHED __builtin_amdgcn_sched_barrier(0)
    Unit cur, nxt, nn; int ui = 0;
    if (!S.next(0, cur)) return;
    f32x4 acc[2][2][4][2];
    if constexpr (!FP8) {
#pragma unroll
    for (int a = 0; a < 2; ++a)
#pragma unroll
        for (int b = 0; b < 2; ++b)
#pragma unroll
            for (int m = 0; m < 4; ++m)
#pragma unroll
                for (int n = 0; n < 2; ++n) acc[a][b][m][n] = (f32x4){0.f, 0.f, 0.f, 0.f};
    }
    bf16x8 At[4][2], B0[2][2], B1[2][2];
    unsigned ca[2][2], na[2][2]; int ix[2][2];
    S.a_rows(cur, Rp, ix);
#pragma unroll
    for (int h = 0; h < 2; ++h)
#pragma unroll
        for (int i = 0; i < 2; ++i) ca[h][i] = (unsigned)ix[h][i] * rowb + cb[i];
    bool has1 = S.next(1, nxt);
    if (has1) S.a_rows(nxt, Rp, ix);
    const char* cB = cur.B;
    if constexpr (SP2) {
        PG8_STAGEB(PG8_SB(0, 0), cB, 0); PG8_STAGEB(PG8_SB(0, 1), cB, 1); PG8_STAGEA(PG8_SA(0, 0), 0, ca[0]); PG8_STAGEA(PG8_SA(0, 1), 0, ca[1]);
        if (wr == 1) PG8_BAR;
        PG8_WAIT_V(2); PG8_BAR;
        PG8_STAGEB(PG8_SB(1, 0), cB + kstep, 0); PG8_STAGEA(PG8_SA(1, 0), kstep, ca[0]); PG8_STAGEB(PG8_SB(1, 1), cB + kstep, 1);
        PG8_WAIT_V(6); PG8_BAR;
        if constexpr (FP8) { PG8_STAGEA(PG8_SA(1, 1), kstep, ca[1]);
          u32x4* dz = (u32x4*)dummy + (size_t)(blockIdx.x * 512 + tid) * 16;
#pragma unroll
          for (int q_ = 0; q_ < Epi::NSTORE; ++q_) dz[q_] = (u32x4){0u, 0u, 0u, 0u}; asm volatile("" ::: "memory"); }
    } else {
    PG8_STAGEB(PG8_SB(0, 0), cB, 0); PG8_STAGEA(PG8_SA(0, 0), 0, ca[0]); PG8_STAGEB(PG8_SB(0, 1), cB, 1); PG8_STAGEA(PG8_SA(0, 1), 0, ca[1]);
    if (wr == 1) PG8_BAR;
    PG8_WAIT_V(4); PG8_BAR;
    PG8_STAGEB(PG8_SB(1, 0), cB + kstep, 0); PG8_STAGEA(PG8_SA(1, 0), kstep, ca[0]); PG8_STAGEB(PG8_SB(1, 1), cB + kstep, 1);
    PG8_WAIT_V(6); PG8_BAR;
    }
    for (;;) {
        const bool has_next = has1;
#pragma unroll
        for (int h = 0; h < 2; ++h)
#pragma unroll
            for (int i = 0; i < 2; ++i) na[h][i] = has_next ? ((unsigned)ix[h][i] * rowb + cb[i]) : ca[h][i];
        bool has2 = false;
        if (has_next) { has2 = S.next(ui + 2, nn); if (has2) S.a_rows(nn, Rp, ix); }
        const char* nB = has_next ? nxt.B : cB;
        if constexpr (SP2) {
            if constexpr (FP8) {
                const size_t k1 = kstep, k2 = 2 * kstep, k3 = 3 * kstep;
                const unsigned (&sa0)[2] = ca[0]; const unsigned (&sa1)[2] = ca[1];
                const char* b2 = cB + k2; const char* b3 = b2 + kstep;
            PG8_LDB(B0, 0, 0); PG8_LDB(B1, 0, 1); PG8_SCHED; PG8_LDA(At, 0, 0);
            PG8_WAIT_VR;
            PG8_WAIT_L(0); PG8_BAR; PG8_MMA0(0, 0, At, B0); PG8_MMA0(0, 1, At, B1); PG8_BAR; PG8_SCHED;
            PG8_LDA(At, 0, 1); PG8_STAGEB(PG8_SB(0, 0), b2, 0); PG8_STAGEB(PG8_SB(0, 1), b2, 1); PG8_STAGEA(PG8_SA(0, 0), k2, sa0);
            PG8_WAIT_VR;
            PG8_WAIT_L(0); PG8_BAR; PG8_MMA0(1, 0, At, B0); PG8_MMA0(1, 1, At, B1); PG8_BAR; PG8_SCHED;
            PG8_LDB(B0, 1, 0); PG8_LDB(B1, 1, 1); PG8_SCHED; PG8_LDA(At, 1, 0); PG8_STAGEA(PG8_SA(0, 1), k2, sa1);
            PG8_WAIT_VR; PG8_WAIT_L(0); PG8_BAR; PG8_MMA(0, 0, At, B0); PG8_MMA(0, 1, At, B1); PG8_BAR; PG8_SCHED;
            PG8_LDA(At, 1, 1); PG8_STAGEB(PG8_SB(1, 0), b3, 0); PG8_STAGEB(PG8_SB(1, 1), b3, 1); PG8_STAGEA(PG8_SA(1, 0), k3, sa0);
            PG8_WAIT_V(8); PG8_WAIT_L(0); PG8_BAR; PG8_MMA(1, 0, At, B0); PG8_MMA(1, 1, At, B1); PG8_BAR; PG8_SCHED;
            }
        for (int t = FP8 ? 2 : 0; t < nt; t += 2) {
            const bool last = (t == nt - 2);
            const size_t k1 = (size_t)(t + 1) * kstep;
            const size_t k2 = last ? (size_t)0 : (size_t)(t + 2) * kstep, k3 = k2 + kstep;
            unsigned sa0[2], sa1[2];
#pragma unroll
            for (int i = 0; i < 2; ++i) { sa0[i] = last ? na[0][i] : ca[0][i]; sa1[i] = last ? na[1][i] : ca[1][i]; }
            const char* b2 = last ? nB : cB + k2; const char* b3 = b2 + kstep;
            PG8_LDB(B0, 0, 0); PG8_LDB(B1, 0, 1); PG8_SCHED; PG8_LDA(At, 0, 0); PG8_STAGEA(PG8_SA(1, 1), k1, ca[1]);
            PG8_WAIT_V(8);
            PG8_WAIT_L(0); PG8_BAR; PG8_MMA(0, 0, At, B0); PG8_MMA(0, 1, At, B1); PG8_BAR; PG8_SCHED;
            PG8_LDA(At, 0, 1); PG8_STAGEB(PG8_SB(0, 0), b2, 0); PG8_STAGEB(PG8_SB(0, 1), b2, 1); PG8_STAGEA(PG8_SA(0, 0), k2, sa0);
            PG8_WAIT_V(8);
            PG8_WAIT_L(0); PG8_BAR; PG8_MMA(1, 0, At, B0); PG8_MMA(1, 1, At, B1); PG8_BAR; PG8_SCHED;
            PG8_LDB(B0, 1, 0); PG8_LDB(B1, 1, 1); PG8_SCHED; PG8_LDA(At, 1, 0); PG8_STAGEA(PG8_SA(0, 1), k2, sa1);
            PG8_WAIT_V(8); PG8_WAIT_L(0); PG8_BAR; PG8_MMA(0, 0, At, B0); PG8_MMA(0, 1, At, B1); PG8_BAR; PG8_SCHED;
            PG8_LDA(At, 1, 1); PG8_STAGEB(PG8_SB(1, 0), b3, 0); PG8_STAGEB(PG8_SB(1, 1), b3, 1); PG8_STAGEA(PG8_SA(1, 0), k3, sa0);
            PG8_WAIT_V(8); PG8_WAIT_L(0); PG8_BAR; PG8_MMA(1, 0, At, B0); PG8_MMA(1, 1, At, B1); PG8_BAR; PG8_SCHED;
        }
        } else {
        for (int t = 0; t < nt; t += 2) {
            const bool last = (t == nt - 2);
            const size_t k1 = (size_t)(t + 1) * kstep;
            const size_t k2 = last ? (size_t)0 : (size_t)(t + 2) * kstep, k3 = k2 + kstep;
            unsigned sa0[2], sa1[2];
#pragma unroll
            for (int i = 0; i < 2; ++i) { sa0[i] = last ? na[0][i] : ca[0][i]; sa1[i] = last ? na[1][i] : ca[1][i]; }
            const char* b2 = last ? nB : cB + k2; const char* b3 = b2 + kstep;
            PG8_LDB(B0, 0, 0); PG8_SCHED; PG8_LDA(At, 0, 0); PG8_STAGEA(PG8_SA(1, 1), k1, ca[1]);
            PG8_WAIT_L(8); PG8_BAR; PG8_WAIT_L(0); PG8_MMA(0, 0, At, B0); PG8_BAR; PG8_SCHED;
            PG8_LDB(B1, 0, 1); PG8_STAGEB(PG8_SB(0, 0), b2, 0);
            PG8_BAR; PG8_WAIT_L(0); PG8_MMA(0, 1, At, B1); PG8_BAR;
            PG8_LDA(At, 0, 1); PG8_STAGEA(PG8_SA(0, 0), k2, sa0);
            PG8_BAR; PG8_WAIT_L(0); PG8_MMA(1, 0, At, B0); PG8_BAR; PG8_SCHED;
            PG8_STAGEB(PG8_SB(0, 1), b2, 1);
            PG8_WAIT_V(6); PG8_BAR; PG8_MMA(1, 1, At, B1); PG8_BAR;
            PG8_LDB(B0, 1, 0); PG8_SCHED; PG8_LDA(At, 1, 0); PG8_STAGEA(PG8_SA(0, 1), k2, sa1);
            PG8_WAIT_L(8); PG8_BAR; PG8_WAIT_L(0); PG8_MMA(0, 0, At, B0); PG8_BAR; PG8_SCHED;
            PG8_LDB(B1, 1, 1); PG8_STAGEB(PG8_SB(1, 0), b3, 0);
            PG8_BAR; PG8_WAIT_L(0); PG8_MMA(0, 1, At, B1); PG8_BAR;
            PG8_LDA(At, 1, 1); PG8_STAGEA(PG8_SA(1, 0), k3, sa0);
            PG8_BAR; PG8_WAIT_L(0); PG8_MMA(1, 0, At, B0); PG8_BAR; PG8_SCHED;
            PG8_STAGEB(PG8_SB(1, 1), b3, 1);
            PG8_WAIT_V(6); PG8_BAR; PG8_MMA(1, 1, At, B1); PG8_BAR;
        }
        }
        if constexpr (FP8) PG8_STAGEA(PG8_SA(1, 1), kstep, na[1]);
        if constexpr (ALIGN_EPI) { if (wr == 0) PG8_BAR; }
        if constexpr (FP8) asm volatile("s_nop 15\n\ts_nop 15" ::: "memory");
        E(acc, cur, wr, wc, fr, fq);
        if (!has_next) break;
        if constexpr (!FP8) {
#pragma unroll
        for (int a = 0; a < 2; ++a)
#pragma unroll
            for (int b = 0; b < 2; ++b)
#pragma unroll
                for (int m = 0; m < 4; ++m)
#pragma unroll
                    for (int n = 0; n < 2; ++n) acc[a][b][m][n] = (f32x4){0.f, 0.f, 0.f, 0.f};
        }
        cur = nxt; nxt = nn; has1 = has2; cB = nB; ++ui;
        if constexpr (ALIGN_EPI) { if (wr == 1) PG8_BAR; }
#pragma unroll
        for (int h = 0; h < 2; ++h)
#pragma unroll
            for (int i = 0; i < 2; ++i) ca[h][i] = na[h][i];
    }
    PG8_WAIT_V(0);
    if constexpr (!ALIGN_EPI) { if (wr == 0) PG8_BAR; }
    PG8_BAR;
#undef PG8_SA
#undef PG8_SB
#undef PG8_STAGEA
#undef PG8_STAGEB
#undef PG8_LDA
#undef PG8_LDB
#undef PG8_MMA
#undef PG8_CAT8
#undef PG8_WAIT_V
#undef PG8_WAIT_VR
#undef PG8_MMA0
#undef PG8_WAIT_L
#undef PG8_BAR
#undef PG8_SCHED
}
}

struct TrItem { const float* W; int ldw, k0, n0; bf16_t* WT; int ldk, drow0; bf16_t* WL; float sc8; };
__device__ __forceinline__ void tr_load(const TrItem& t, f32x4 (&v)[8], int lane) {
    const float* src = t.W + (size_t)(t.k0 + (lane >> 3)) * t.ldw + t.n0 + 4 * (lane & 7);
#pragma unroll
    for (int i = 0; i < 8; ++i) v[i] = *(const f32x4*)(src + (size_t)(8 * i) * t.ldw);
}
__device__ __forceinline__ void tr_store(const TrItem& t, const f32x4 (&v)[8], LAS float* scr, int lane) {
    LAS float* wp = scr + (lane >> 3) * 33 + 4 * (lane & 7);
#pragma unroll
    for (int i = 0; i < 8; ++i) { wp[(8 * i) * 33 + 0] = v[i][0]; wp[(8 * i) * 33 + 1] = v[i][1]; wp[(8 * i) * 33 + 2] = v[i][2]; wp[(8 * i) * 33 + 3] = v[i][3]; }
    LDS_WAIT(); asm volatile("" ::: "memory");
    const int c = lane & 7;
#pragma unroll
    for (int j = 0; j < 4; ++j) { const int n = (lane >> 3) + 8 * j; const LAS float* sp = scr + (8 * c) * 33 + n;
        float x[8];
#pragma unroll
        for (int q = 0; q < 8; ++q) x[q] = sp[q * 33];
        if (t.WL) {
            const int e = t.drow0 + n, k = t.k0 + 8 * c; const size_t off = ((size_t)(((k >> 10) * 4 + (e >> 4)) * 32 + ((k >> 5) & 31)) * 64 + ((k >> 3) & 3) * 16 + (e & 15)) * 8;
            unsigned hw[4], lw[4];
#pragma unroll
            for (int q = 0; q < 4; ++q) { hw[q] = cvt_pk_bf16(x[2 * q], x[2 * q + 1]); lw[q] = cvt_pk_bf16(x[2 * q] - bf_lo(hw[q]), x[2 * q + 1] - bf_hi(hw[q])); }
            *(u32x4*)(t.WT + off) = (u32x4){hw[0], hw[1], hw[2], hw[3]}; *(u32x4*)(t.WL + off) = (u32x4){lw[0], lw[1], lw[2], lw[3]}; continue; }
        if (t.sc8 > 0.f) { int d0 = 0, d1 = 0; const float s8 = t.sc8;
            d0 = __builtin_amdgcn_cvt_pk_fp8_f32(x[0] * s8, x[1] * s8, d0, false); d0 = __builtin_amdgcn_cvt_pk_fp8_f32(x[2] * s8, x[3] * s8, d0, true);
            d1 = __builtin_amdgcn_cvt_pk_fp8_f32(x[4] * s8, x[5] * s8, d1, false); d1 = __builtin_amdgcn_cvt_pk_fp8_f32(x[6] * s8, x[7] * s8, d1, true);
            *(u32x2*)((unsigned char*)t.WT + (size_t)(t.drow0 + n) * t.ldk + t.k0 + 8 * c) = (u32x2){(unsigned)d0, (unsigned)d1}; continue; }
        unsigned hw[4];
#pragma unroll
        for (int q = 0; q < 4; ++q) hw[q] = cvt_pk_bf16(x[2 * q], x[2 * q + 1]);
        *(u32x4*)(t.WT + (size_t)(t.drow0 + n) * t.ldk + t.k0 + 8 * c) = (u32x4){hw[0], hw[1], hw[2], hw[3]}; }
    LDS_WAIT(); asm volatile("" ::: "memory");
}
template <class Dec>
__device__ __forceinline__ void tr_run(const Dec& dec, int first, int stride, int end, LAS float* scr, int lane) {
    if (first >= end) return;
    f32x4 va[8], vb[8]; TrItem ia, ib;
    dec(first, ia); tr_load(ia, va, lane);
    for (int it = first; ; it += 2 * stride) {
        const bool hb = it + stride < end;
        if (hb) { dec(it + stride, ib); tr_load(ib, vb, lane); }
        tr_store(ia, va, scr, lane);
        if (!hb) break;
        const bool ha = it + 2 * stride < end;
        if (ha) { dec(it + 2 * stride, ia); tr_load(ia, va, lane); }
        tr_store(ib, vb, scr, lane);
        if (!ha) break;
    }
}

__device__ __forceinline__ void phase_prologue(const Params& p, LAS unsigned char* lds, int bid, int nblk) {
    const int tid = threadIdx.x, lane = tid & 63, wave = __builtin_amdgcn_readfirstlane(tid >> 6);
    unsigned char* ws = p.ws;
    float* mod = (float*)(ws + WS_MOD);
    for (int cg = bid; cg < MODW / 64; cg += nblk) {
        LAS float* sl = (LAS float*)lds;
        for (int i = tid; i < NBATCH * DM; i += NTHREADS) sl[i] = fsilu(p.c[i]);
        __syncthreads();
        const int n = cg * 64 + lane, k0 = wave * 256;
        float a[8] = {0.f, 0.f, 0.f, 0.f, 0.f, 0.f, 0.f, 0.f};
        for (int k = k0; k < k0 + 256; k += 32) {
            float w[32];
#pragma unroll
            for (int u = 0; u < 32; ++u) w[u] = p.w_ada[(size_t)(k + u) * MODW + n];
#pragma unroll
            for (int u = 0; u < 32; ++u)
#pragma unroll
                for (int b = 0; b < 8; ++b) a[b] += sl[b * DM + k + u] * w[u];
        }
        LAS float* part = sl + NBATCH * DM;
#pragma unroll
        for (int b = 0; b < 8; ++b) part[(wave * 8 + b) * 64 + lane] = a[b];
        __syncthreads();
        { const int b = tid >> 6; float s = 0.f;
#pragma unroll
            for (int w = 0; w < 8; ++w) s += part[(w * 8 + b) * 64 + lane];
            mod[b * MODW + cg * 64 + lane] = s + p.b_ada[cg * 64 + lane]; }
        __syncthreads();
    }
    if (bid == nblk - 1) { float* gw = (float*)(ws + WS_GATEW);
        for (int i = tid; i < 8 * DM; i += NTHREADS) { const int g = i >> 11, k = i & (DM - 1); gw[i] = p.w_in[(size_t)k * INW + INWM + g]; } }
    LAS float* scr = (LAS float*)(lds + wave * 16384);
    const int gw = bid * NWAVES + wave, NGW = nblk * NWAVES;
    constexpr int I_IN = 32 * 224, I_OUT = 32 * 64, I_SG = 32 * 16, I_SD = 8 * 64, I_R = 32 * 2;
    constexpr int NIT = I_IN + I_OUT + 2 * I_SG + I_SD + I_R;
    bf16_t* WIN = (bf16_t*)(ws + WS_WIN); bf16_t* WOUT = (bf16_t*)(ws + WS_WOUT);
    bf16_t* WGUs = (bf16_t*)(ws + WS_WGU + (size_t)NE * 1024 * DM); bf16_t* WDs = (bf16_t*)(ws + WS_WD + (size_t)NE * DM * FE);
    bf16_t* WRH = (bf16_t*)(ws + WS_WRHI); bf16_t* WRL = (bf16_t*)(ws + WS_WRLO);
    auto dec = [&](int it, TrItem& t) {
        int r = it; t.WL = nullptr;
        if (r < I_IN) { const int kb = r / 224, nb = r % 224; t = TrItem{p.w_in, INW, 64 * kb, 32 * nb, WIN, DM, 32 * nb, nullptr, 0.f}; return; } r -= I_IN;
        if (r < I_OUT) { const int kb = r / 64, nb = r % 64; t = TrItem{p.w_out, DM, 64 * kb, 32 * nb, WOUT, DM, 32 * nb, nullptr, 0.f}; return; } r -= I_OUT;
        if (r < I_SG) { const int kb = r / 16, nb = r % 16, n0 = 32 * nb; t = TrItem{p.ws_gate, FE, 64 * kb, n0, WGUs, DM, 256 * (n0 >> 7) + (n0 & 127), nullptr, 64.f}; return; } r -= I_SG;
        if (r < I_SG) { const int kb = r / 16, nb = r % 16, n0 = 32 * nb; t = TrItem{p.ws_up, FE, 64 * kb, n0, WGUs, DM, 256 * (n0 >> 7) + 128 + (n0 & 127), nullptr, 64.f}; return; } r -= I_SG;
        if (r < I_SD) { const int kb = r / 64, nb = r % 64; t = TrItem{p.ws_down, DM, 64 * kb, 32 * nb, WDs, FE, 32 * nb, nullptr, 64.f}; return; } r -= I_SD;
        { const int kb = r / 2, nb = r % 2; t = TrItem{p.w_router, NE, 64 * kb, 32 * nb, WRH, DM, 32 * nb, WRL, 0.f}; }
    };
    tr_run(dec, gw, NGW, NIT, scr, lane);
}

__device__ __forceinline__ void expert_convert(const Params& p, LAS unsigned char* lds, int qidx = 0) {
    const int lane = threadIdx.x & 63, wave = __builtin_amdgcn_readfirstlane(threadIdx.x >> 6);
    unsigned* q = (unsigned*)(p.ws + WS_CTL) + CW_QUEUE + 64 * qidx;
    LAS float* scr = (LAS float*)(lds + wave * 16384);
    unsigned char* WGU = p.ws + WS_WGU; unsigned char* WD = p.ws + WS_WD;
    constexpr unsigned NITEMS = 64u * 1536u, CH = 16u;
    auto dec = [&](int it, TrItem& t) {
        const int e = it / 1536; int r = it % 1536;
        if (r < 512) { const int kb = r / 16, nb = r % 16, n0 = 32 * nb; t = TrItem{p.w_gate + (size_t)e * DM * FE, FE, 64 * kb, n0, (bf16_t*)(WGU + (size_t)e * 1024 * DM), DM, 256 * (n0 >> 7) + (n0 & 127), nullptr, 64.f}; }
        else if (r < 1024) { r -= 512; const int kb = r / 16, nb = r % 16, n0 = 32 * nb; t = TrItem{p.w_up + (size_t)e * DM * FE, FE, 64 * kb, n0, (bf16_t*)(WGU + (size_t)e * 1024 * DM), DM, 256 * (n0 >> 7) + 128 + (n0 & 127), nullptr, 64.f}; }
        else { r -= 1024; const int kb = r / 64, nb = r % 64; t = TrItem{p.w_down + (size_t)e * FE * DM, DM, 64 * kb, 32 * nb, (bf16_t*)(WD + (size_t)e * DM * FE), FE, 32 * nb, nullptr, 64.f}; }
    };
    for (;;) {
        unsigned base = 0; if (lane == 0) base = __hip_atomic_fetch_add(q, CH, __ATOMIC_RELAXED, __HIP_MEMORY_SCOPE_AGENT);
        base = __builtin_amdgcn_readfirstlane(base);
        if (base >= NITEMS) break;
        tr_run(dec, (int)base, 1, (int)(base + CH), scr, lane);
    }
}

__device__ __forceinline__ void phase_modulate(const Params& p, LAS unsigned char* lds, int bid, int nblk) {
    const int tid = threadIdx.x, lane = tid & 63, wave = __builtin_amdgcn_readfirstlane(tid >> 6);
    const float* mod = (const float*)(p.ws + WS_MOD); const float* gwg = (const float*)(p.ws + WS_GATEW);
    float* gates = (float*)(p.ws + WS_GATES); bf16_t* U1 = (bf16_t*)(p.ws + WS_RA);
    LAS float* sc = (LAS float*)lds; LAS float* sh = sc + DM; LAS float* gw = sh + DM;
    const int rows_per = T / nblk;
    const int row_lo = bid * rows_per, b = row_lo / SEQ;
    for (int i = tid; i < DM; i += NTHREADS) { sh[i] = mod[b * MODW + i]; sc[i] = 1.0f + mod[b * MODW + DM + i]; }
    for (int i = tid; i < 8 * DM; i += NTHREADS) gw[i] = gwg[i];
    __syncthreads();
    for (int r0 = row_lo + 2 * wave; r0 < row_lo + rows_per; r0 += 2 * NWAVES) {
        f32x4 xv[2][8];
#pragma unroll
        for (int q = 0; q < 2; ++q)
#pragma unroll
            for (int j = 0; j < 8; ++j) xv[q][j] = __builtin_nontemporal_load((const f32x4*)(p.x + (size_t)(r0 + q) * DM) + lane + 64 * j);
#pragma unroll
        for (int q = 0; q < 2; ++q) {
            const int r = r0 + q;
            u32x2* ur = (u32x2*)(U1 + (size_t)r * DM) + lane;
            float a[8] = {0.f, 0.f, 0.f, 0.f, 0.f, 0.f, 0.f, 0.f};
#pragma unroll
            for (int j = 0; j < 8; ++j) {
                const int col = 4 * lane + 256 * j;
                const f32x4 s = *(const LAS f32x4*)(sc + col), h = *(const LAS f32x4*)(sh + col);
                const f32x4 u = xv[q][j] * s + h;
                ur[64 * j] = (u32x2){cvt_pk_bf16(u[0], u[1]), cvt_pk_bf16(u[2], u[3])};
#pragma unroll
                for (int g = 0; g < 8; ++g) { const f32x4 w = *(const LAS f32x4*)(gw + g * DM + col); a[g] += (u[0] * w[0] + u[1] * w[1]) + (u[2] * w[2] + u[3] * w[3]); }
                asm volatile("" ::: "memory");
            }
#pragma unroll
            for (int g = 0; g < 8; ++g) a[g] = wave_sum(a[g]);
            float o = a[0];
#pragma unroll
            for (int g = 1; g < 8; ++g) o = (lane == g) ? a[g] : o;
            if (lane < 8) gates[(size_t)r * 8 + lane] = o + p.b_gates[lane];
        }
    }
}

__device__ __forceinline__ void retention_naive(const Params& p, LAS unsigned char* lds, int b, int h) {
    const int tid = threadIdx.x, v = tid & 255, dh = tid >> 8;
    const bf16_t* proj = (const bf16_t*)(p.ws + WS_RB); bf16_t* outp = (bf16_t*)(p.ws + WS_RC);
    constexpr int TB = 8;
    LAS float* qs = (LAS float*)lds; LAS float* ks = qs + TB * 256; LAS float* vs = ks + TB * 256; LAS float* red = vs + TB * 256;
    const float g = 1.0f - __builtin_amdgcn_exp2f(-5.0f - (float)h);
    float S[128];
#pragma unroll
    for (int d = 0; d < 128; ++d) S[d] = 0.f;
    for (int t0 = 0; t0 < SEQ; t0 += TB) {
        for (int i = tid; i < TB * 256; i += NTHREADS) { const int s = i >> 8, c = i & 255; const size_t rb = (size_t)(b * SEQ + t0 + s) * INWM;
            qs[i] = bf2f(proj[rb + PC_RQ + h * 256 + c]); ks[i] = bf2f(proj[rb + PC_RK + h * 256 + c]); vs[i] = bf2f(proj[rb + PC_RV + h * 256 + c]); }
        __syncthreads();
        for (int s = 0; s < TB; ++s) {
            const float vv = vs[s * 256 + v]; float o = 0.f;
            const LAS f32x4* q4 = (const LAS f32x4*)(qs + s * 256 + dh * 128); const LAS f32x4* k4 = (const LAS f32x4*)(ks + s * 256 + dh * 128);
#pragma unroll
            for (int d4 = 0; d4 < 32; ++d4) { const f32x4 q = q4[d4], k = k4[d4];
#pragma unroll
                for (int j = 0; j < 4; ++j) { S[4 * d4 + j] = g * S[4 * d4 + j] + k[j] * vv; o += q[j] * S[4 * d4 + j]; } }
            red[(s * 2 + dh) * 256 + v] = o;
        }
        __syncthreads();
        for (int i = tid; i < TB * 256; i += NTHREADS) { const int s = i >> 8, c = i & 255;
            const float o = red[(s * 2) * 256 + c] + red[(s * 2 + 1) * 256 + c];
            outp[(size_t)(b * SEQ + t0 + s) * DM + h * 256 + c] = (bf16_t)(cvt_pk_bf16(o, 0.f) & 0xffffu); }
        __syncthreads();
    }
}
__device__ __forceinline__ void mlstm_naive(const Params& p, LAS unsigned char* lds, int b, int h) {
    const int tid = threadIdx.x, v = tid & 255, dh = tid >> 8;
    const bf16_t* proj = (const bf16_t*)(p.ws + WS_RB); bf16_t* outp = (bf16_t*)(p.ws + WS_RC); const float* gates = (const float*)(p.ws + WS_GATES);
    constexpr int TB = 8;
    LAS float* raw = (LAS float*)lds;
    LAS float* qs = raw + (TB + 3) * 256;
    LAS float* ks = qs + TB * 128;
    LAS float* vs = ks + TB * 128;
    LAS float* red = vs + TB * 256;
    LAS float* rden = red + TB * 2 * 256;
    LAS float* gsc = rden + TB * 2;
    float C[64], n[64];
#pragma unroll
    for (int d = 0; d < 64; ++d) { C[d] = 0.f; n[d] = 0.f; }
    float mrun = 0.f;
    for (int t0 = 0; t0 < SEQ; t0 += TB) {
        for (int i = tid; i < (TB + 3) * 256; i += NTHREADS) { const int s = i >> 8, c = i & 255; const int t = t0 - 3 + s;
            const int col = (c < 128) ? (PC_MQK + h * 128 + c) : (PC_MQK + 512 + h * 128 + (c - 128));
            raw[i] = (t >= 0) ? bf2f(proj[(size_t)(b * SEQ + t) * INWM + col]) : 0.f; }
        for (int i = tid; i < TB * 256; i += NTHREADS) { const int s = i >> 8, c = i & 255; vs[i] = bf2f(proj[(size_t)(b * SEQ + t0 + s) * INWM + PC_MV + h * 256 + c]); }
        __syncthreads();
        for (int i = tid; i < TB * 256; i += NTHREADS) { const int s = i >> 8, c = i & 255;
            const int ch = (c < 128) ? (h * 128 + c) : (512 + h * 128 + (c - 128));
            float a = p.conv_b[ch];
#pragma unroll
            for (int w = 0; w < 4; ++w) a += raw[(s + w) * 256 + c] * p.conv_w[w * 1024 + ch];
            a = fsilu(a);
            if (c < 128) qs[s * 128 + c] = a * 0.08838834764831845f; else ks[s * 128 + (c - 128)] = a; }
        if (tid == 0) { float m = mrun;
            for (int s = 0; s < TB; ++s) { const size_t r = (size_t)(b * SEQ + t0 + s) * 8; const float ip = gates[r + h], fp = gates[r + 4 + h];
                const float lf = fminf(fp, 0.f) - log1pf(__expf(-fabsf(fp)));
                const float mn = fmaxf(lf + m, ip);
                gsc[s * 3 + 0] = __expf(lf + m - mn); gsc[s * 3 + 1] = __expf(ip - mn); gsc[s * 3 + 2] = __expf(-mn); m = mn; }
            gsc[TB * 3] = m; }
        __syncthreads();
        mrun = gsc[TB * 3];
        for (int s = 0; s < TB; ++s) {
            const float fs = gsc[s * 3], is = gsc[s * 3 + 1];
            const float vv = vs[s * 256 + v] * is; float num = 0.f, den = 0.f;
            const LAS f32x4* q4 = (const LAS f32x4*)(qs + s * 128 + dh * 64); const LAS f32x4* k4 = (const LAS f32x4*)(ks + s * 128 + dh * 64);
#pragma unroll
            for (int d4 = 0; d4 < 16; ++d4) { const f32x4 q = q4[d4], k = k4[d4];
#pragma unroll
                for (int j = 0; j < 4; ++j) { C[4 * d4 + j] = fs * C[4 * d4 + j] + k[j] * vv; n[4 * d4 + j] = fs * n[4 * d4 + j] + is * k[j];
                    num += q[j] * C[4 * d4 + j]; den += q[j] * n[4 * d4 + j]; } }
            red[(s * 2 + dh) * 256 + v] = num;
            if (v == 0) rden[s * 2 + dh] = den;
        }
        __syncthreads();
        for (int i = tid; i < TB * 256; i += NTHREADS) { const int s = i >> 8, c = i & 255;
            const float num = red[(s * 2) * 256 + c] + red[(s * 2 + 1) * 256 + c], den = rden[s * 2] + rden[s * 2 + 1];
            const float o = num / fmaxf(fabsf(den), gsc[s * 3 + 2]);
            outp[(size_t)(b * SEQ + t0 + s) * DM + 1024 + h * 256 + c] = (bf16_t)(cvt_pk_bf16(o, 0.f) & 0xffffu); }
        __syncthreads();
    }
}
typedef short s16x4 __attribute__((ext_vector_type(4)));
__device__ __forceinline__ bf16x8 cat4(s16x4 a, s16x4 b) { return __builtin_shufflevector(a, b, 0, 1, 2, 3, 4, 5, 6, 7); }
__device__ __forceinline__ s16x4 tr_read(LAS const unsigned char* q) { return __builtin_amdgcn_ds_read_tr16_b64_v4i16((LAS s16x4*)q); }
__device__ __forceinline__ void unpack8(const u32x4 v, float (&x)[8]) { x[0] = bf_lo(v.x); x[1] = bf_hi(v.x); x[2] = bf_lo(v.y); x[3] = bf_hi(v.y); x[4] = bf_lo(v.z); x[5] = bf_hi(v.z); x[6] = bf_lo(v.w); x[7] = bf_hi(v.w); }
__device__ __forceinline__ u32x4 pack8(const float (&x)[8]) { return (u32x4){cvt_pk_bf16(x[0], x[1]), cvt_pk_bf16(x[2], x[3]), cvt_pk_bf16(x[4], x[5]), cvt_pk_bf16(x[6], x[7])}; }

#define BAR_LDS() do { asm volatile("s_waitcnt lgkmcnt(0)" ::: "memory"); __builtin_amdgcn_s_barrier(); asm volatile("" ::: "memory"); } while (0)
__device__ __forceinline__ void phase_conv(const Params& p, LAS unsigned char* lds, int bid, int nblk) {
    const int tid = threadIdx.x;
    const bf16_t* proj = (const bf16_t*)(p.ws + WS_RB); bf16_t* outc = (bf16_t*)(p.ws + WS_CONV);
    LAS float* cw = (LAS float*)lds;
    for (int i = tid; i < 5 * 1024; i += NTHREADS) cw[i] = (i < 4096) ? p.conv_w[i] : p.conv_b[i - 4096];
    __syncthreads();
    const int rows_per = T / nblk, row_lo = bid * rows_per;
    for (int it = tid; it < (rows_per / 4) * 128; it += NTHREADS) {
        const int rq = it >> 7, cg = it & 127, c0 = 8 * cg, t0 = row_lo + 4 * rq, s0 = t0 & (SEQ - 1);
        float x[7][8];
#pragma unroll
        for (int u = 0; u < 7; ++u) { u32x4 v = (u32x4){0u, 0u, 0u, 0u}; if (s0 - 3 + u >= 0) v = *(const u32x4*)(proj + (size_t)(t0 - 3 + u) * INWM + PC_MQK + c0); unpack8(v, x[u]); }
        f32x4 wv[5][2];
#pragma unroll
        for (int u = 0; u < 5; ++u) { wv[u][0] = *(const LAS f32x4*)(cw + u * 1024 + c0); wv[u][1] = *(const LAS f32x4*)(cw + u * 1024 + c0 + 4); }
        const float qs = (c0 < 512) ? 0.08838834764831845f : 1.0f;
#pragma unroll
        for (int r = 0; r < 4; ++r) { float a[8];
#pragma unroll
            for (int e = 0; e < 8; ++e) { float acc = wv[4][e >> 2][e & 3];
#pragma unroll
                for (int u = 0; u < 4; ++u) acc += x[r + u][e] * wv[u][e >> 2][e & 3];
                a[e] = fsilu(acc) * qs; }
            *(u32x4*)(outc + (size_t)(t0 + r) * 1024 + c0) = pack8(a); }
    }
}

template <int DK, bool ML>
__device__ __forceinline__ void chain_mfma(const Params& p, LAS unsigned char* lds, int b, int h, int vh, float* gscr) {
    constexpr int PQ = DK * 2 + 16, PV = 272, PP = 144, NDT = DK / 16, NKS = DK / 32, NC = SEQ / 64, NPQ = DK / 64;
    constexpr int O_QS = 0, O_KS = 64 * PQ, O_VS = 128 * PQ, O_VP = O_VS + 64 * PV, O_PS = O_VP + 64 * PV, O_OB = O_PS + 64 * PP, O_VEC = O_OB + 64 * PV;
    static_assert(O_VEC + 8192 <= BARW_OFF, "chain LDS map");
    LAS float* rowterm = (LAS float*)(lds + O_VEC); LAS float* cterm = rowterm + 64; LAS float* winter = cterm + 64; LAS float* enm = winter + 64; LAS float* gkv = enm + 64;
    LAS float* cb63 = gkv + 64;
    LAS float* ccm = cb63 + 64;
    LAS float* cmp_ = ccm + 64;
    LAS float* cmn = cmp_ + 64;
    const int tid = threadIdx.x, lane = tid & 63, w = __builtin_amdgcn_readfirstlane(tid >> 6), r16 = lane & 15, kg = lane >> 4, q4 = r16 >> 2, p4 = lane & 3;
    const bf16_t* proj = (const bf16_t*)(p.ws + WS_RB); bf16_t* outp = (bf16_t*)(p.ws + WS_RC); const float* gates = (const float*)(p.ws + WS_GATES);
    const size_t row0 = (size_t)b * SEQ;
    const bf16_t* qsrc = ML ? ((const bf16_t*)(p.ws + WS_CONV) + h * 128) : (proj + PC_RQ + h * 256);
    const bf16_t* ksrc = ML ? ((const bf16_t*)(p.ws + WS_CONV) + 512 + h * 128) : (proj + PC_RK + h * 256);
    constexpr int QLD = ML ? 1024 : INWM;
    const int vcol = (ML ? PC_MV : PC_RV) + h * 256 + vh * 128, ocol = (ML ? 1024 : 0) + h * 256 + vh * 128;
    const float lg = ML ? 0.f : __log2f(1.0f - __builtin_amdgcn_exp2f(-5.0f - (float)h));
    f32x4 S[NDT], Sn[ML ? NDT : 1];
#pragma unroll
    for (int i = 0; i < NDT; ++i) S[i] = (f32x4){0.f, 0.f, 0.f, 0.f};
#pragma unroll
    for (int i = 0; i < (ML ? NDT : 1); ++i) Sn[i] = (f32x4){0.f, 0.f, 0.f, 0.f};
    float gst = 0.f;
    if (ML) {
        float bcr[8], ctr[8], cmr[8];
#pragma unroll
        for (int q = 0; q < 8; ++q) { const int c = w + 8 * q;
            const float gi_ = gates[(row0 + c * 64 + lane) * 8 + h], gf_ = gates[(row0 + c * 64 + lane) * 8 + 4 + h];
            const float lf = fminf(gf_, 0.f) - __logf(1.0f + __expf(-fabsf(gf_)));
            float bc = lf;
#pragma unroll
            for (int o = 1; o < 64; o <<= 1) { const float t = __shfl_up(bc, o); if (lane >= o) bc += t; }
            const float ct = gi_ - bc; float cm = ct;
#pragma unroll
            for (int o = 1; o < 64; o <<= 1) { const float t = __shfl_up(cm, o); if (lane >= o) cm = fmaxf(cm, t); }
            bcr[q] = bc; ctr[q] = ct; cmr[q] = cm;
            if (lane == 63) { cb63[c] = bc; ccm[c] = cm; } }
        __syncthreads();
        if (tid == 0) { float m = 0.f; for (int c = 0; c < NC; ++c) { cmp_[c] = m; const float mn = cb63[c] + fmaxf(m, ccm[c]); cmn[c] = mn; gscr[5 * SEQ + c] = __expf(cb63[c] + m - mn); m = mn; } }
        __syncthreads();
#pragma unroll
        for (int q = 0; q < 8; ++q) { const int c = w + 8 * q, f = c * 64 + lane; const float mp = cmp_[c], mn = cmn[c], b63 = cb63[c];
            const float m = bcr[q] + fmaxf(mp, cmr[q]);
            gscr[f] = bcr[q] - m; gscr[SEQ + f] = ctr[q]; gscr[2 * SEQ + f] = __expf(bcr[q] + mp - m); gscr[3 * SEQ + f] = __expf(-m); gscr[4 * SEQ + f] = __expf(b63 + ctr[q] - mn); }
    }
    u32x4 pq[NPQ], pk[NPQ], pv[2]; float g_rt = 0.f, g_ct = 0.f, g_wi = 0.f, g_en = 0.f, g_gk = 0.f, g_st = 0.f;
    int tv = tid;
    auto load_chunk = [&](int c) {
#pragma unroll
        for (int i = 0; i < NPQ; ++i) { const int id = tv + 512 * i, row = id / (DK / 8), pc = id % (DK / 8); const size_t ro = (row0 + c * 64 + row) * QLD + pc * 8;
            pq[i] = *(const u32x4*)(qsrc + ro); pk[i] = *(const u32x4*)(ksrc + ro); }
        if (ML) { const int f = c * 64 + lane;
            g_gk = gscr[4 * SEQ + f]; g_st = gscr[5 * SEQ + c];
            if (w == 0) { g_rt = gscr[f]; g_ct = gscr[SEQ + f]; g_wi = gscr[2 * SEQ + f]; g_en = gscr[3 * SEQ + f]; } }
#pragma unroll
        for (int i = 0; i < 2; ++i) { const int id = tv + 512 * i, row = id >> 4, pc = id & 15; pv[i] = *(const u32x4*)(proj + (row0 + c * 64 + row) * INWM + vcol + pc * 8); }
    };
    auto stage_chunk = [&]() {
#pragma unroll
        for (int i = 0; i < NPQ; ++i) { const int id = tv + 512 * i, row = id / (DK / 8), pc = id % (DK / 8);
            *(LAS u32x4*)(lds + O_QS + row * PQ + pc * 16) = pq[i]; *(LAS u32x4*)(lds + O_KS + row * PQ + pc * 16) = pk[i]; }
        if (ML) { if (w == 0) { rowterm[lane] = g_rt; cterm[lane] = g_ct; winter[lane] = g_wi; enm[lane] = g_en; gkv[lane] = g_gk; }
            gst = g_st; }
#pragma unroll
        for (int i = 0; i < 2; ++i) { const int id = tv + 512 * i, row = id >> 4, pc = id & 15;
            const float sc = ML ? __shfl(g_gk, row) : __builtin_amdgcn_exp2f((float)(63 - row) * lg);
            float x[8]; unpack8(pv[i], x);
#pragma unroll
            for (int e = 0; e < 8; ++e) x[e] *= sc;
            *(LAS u32x4*)(lds + O_VS + row * PV + pc * 16) = pv[i]; *(LAS u32x4*)(lds + O_VP + row * PV + pc * 16) = pack8(x); }
    };
    __syncthreads();
    load_chunk(0);
    stage_chunk();
    __syncthreads();
    for (int c = 0; c < NC; ++c) {
        asm volatile("" : "+v"(tv));
        if (c + 1 < NC) load_chunk(c + 1);
        {
            const int it = w >> 1;
            f32x4 sc[2] = {(f32x4){0.f, 0.f, 0.f, 0.f}, (f32x4){0.f, 0.f, 0.f, 0.f}};
            const LAS unsigned char* qb = lds + O_QS + (16 * it + r16) * PQ + (8 * kg) * 2;
            const LAS unsigned char* kb0 = lds + O_KS + (16 * (2 * (w & 1)) + r16) * PQ + (8 * kg) * 2;
            bf16x8 fa[2], fb0[2], fb1[2];
            fa[0] = *(const LAS bf16x8*)(qb); fb0[0] = *(const LAS bf16x8*)(kb0); fb1[0] = *(const LAS bf16x8*)(kb0 + 16 * PQ);
#pragma unroll
            for (int ks = 0; ks < NKS; ++ks) {
                if (ks + 1 < NKS) { fa[(ks + 1) & 1] = *(const LAS bf16x8*)(qb + 64 * (ks + 1)); fb0[(ks + 1) & 1] = *(const LAS bf16x8*)(kb0 + 64 * (ks + 1)); fb1[(ks + 1) & 1] = *(const LAS bf16x8*)(kb0 + 16 * PQ + 64 * (ks + 1)); }
                sc[0] = __builtin_amdgcn_mfma_f32_16x16x32_bf16(fa[ks & 1], fb0[ks & 1], sc[0], 0, 0, 0);
                sc[1] = __builtin_amdgcn_mfma_f32_16x16x32_bf16(fa[ks & 1], fb1[ks & 1], sc[1], 0, 0, 0);
                __builtin_amdgcn_sched_barrier(0);
            }
#pragma unroll
            for (int jj = 0; jj < 2; ++jj) { const int jt = 2 * (w & 1) + jj, j = 16 * jt + r16; const float ctj = ML ? cterm[j] : 0.f;
                f32x4 rt4 = (f32x4){0.f, 0.f, 0.f, 0.f}; if (ML) rt4 = *(const LAS f32x4*)(rowterm + 16 * it + 4 * kg);
#pragma unroll
                for (int r = 0; r < 4; ++r) { const int i = 16 * it + 4 * kg + r;
                    const float wgt = ML ? __expf(fminf(rt4[r] + ctj, 0.f)) : __builtin_amdgcn_exp2f((float)(i - j) * lg);
                    const float val = (j <= i) ? sc[jj][r] * wgt : 0.f;
                    *(LAS bf16_t*)(lds + O_PS + i * PP + j * 2) = (bf16_t)(cvt_pk_bf16(val, 0.f) & 0xffffu); }
            }
        }
        BAR_LDS();
        {
            bf16x8 bv[2], bvp[2], gkf[2];
#pragma unroll
            for (int ks = 0; ks < 2; ++ks) {
                const LAS unsigned char* a0 = lds + O_VS + (32 * ks + 8 * kg + q4) * PV + (16 * w) * 2 + 8 * p4;
                bv[ks] = cat4(tr_read(a0), tr_read(a0 + 4 * PV));
                const LAS unsigned char* a1 = lds + O_VP + (32 * ks + 8 * kg + q4) * PV + (16 * w) * 2 + 8 * p4;
                bvp[ks] = cat4(tr_read(a1), tr_read(a1 + 4 * PV));
                if (ML) { const f32x4 g0 = *(const LAS f32x4*)(gkv + 32 * ks + 8 * kg), g1 = *(const LAS f32x4*)(gkv + 32 * ks + 8 * kg + 4);
                    gkf[ks] = __builtin_bit_cast(bf16x8, (u32x4){cvt_pk_bf16(g0[0], g0[1]), cvt_pk_bf16(g0[2], g0[3]), cvt_pk_bf16(g1[0], g1[1]), cvt_pk_bf16(g1[2], g1[3])}); }
            }
            const bf16x8 ones = __builtin_bit_cast(bf16x8, (u32x4){0x3f803f80u, 0x3f803f80u, 0x3f803f80u, 0x3f803f80u});
            f32x4 O1[4], O2[4], O1n[ML ? 4 : 1], O2n[ML ? 4 : 1];
            {
                bf16x8 pa[4][2];
#pragma unroll
                for (int it = 0; it < 4; ++it)
#pragma unroll
                    for (int ks = 0; ks < 2; ++ks) pa[it][ks] = *(const LAS bf16x8*)(lds + O_PS + (16 * it + r16) * PP + (32 * ks + 8 * kg) * 2);
                u32x2 ql[2][4], qh[2][4];
                const LAS unsigned char* qa0 = lds + O_QS + r16 * PQ + (4 * kg) * 2;
#pragma unroll
                for (int it = 0; it < 4; ++it) { ql[0][it] = *(const LAS u32x2*)(qa0 + 16 * it * PQ); qh[0][it] = *(const LAS u32x2*)(qa0 + 16 * it * PQ + 32); }
                __builtin_amdgcn_sched_barrier(0);
#pragma unroll
                for (int it = 0; it < 4; ++it) { O1[it] = (f32x4){0.f, 0.f, 0.f, 0.f}; O2[it] = (f32x4){0.f, 0.f, 0.f, 0.f};
                    if (ML) { O1n[it] = (f32x4){0.f, 0.f, 0.f, 0.f}; O2n[it] = (f32x4){0.f, 0.f, 0.f, 0.f}; }
#pragma unroll
                    for (int ks = 0; ks < 2; ++ks) { O1[it] = __builtin_amdgcn_mfma_f32_16x16x32_bf16(pa[it][ks], bv[ks], O1[it], 0, 0, 0);
                        if (ML) O1n[it] = __builtin_amdgcn_mfma_f32_16x16x32_bf16(pa[it][ks], ones, O1n[it], 0, 0, 0); } }
#pragma unroll
                for (int m = 0; m < NKS; ++m) {
                    if (m + 1 < NKS) {
#pragma unroll
                        for (int it = 0; it < 4; ++it) { ql[(m + 1) & 1][it] = *(const LAS u32x2*)(qa0 + 16 * it * PQ + 64 * (m + 1)); qh[(m + 1) & 1][it] = *(const LAS u32x2*)(qa0 + 16 * it * PQ + 64 * (m + 1) + 32); } }
                    const f32x4 s0 = S[2 * m], s1 = S[2 * m + 1];
                    const bf16x8 sb = __builtin_bit_cast(bf16x8, (u32x4){cvt_pk_bf16(s0[0], s0[1]), cvt_pk_bf16(s0[2], s0[3]), cvt_pk_bf16(s1[0], s1[1]), cvt_pk_bf16(s1[2], s1[3])});
                    bf16x8 snb = sb;
                    if (ML) { const f32x4 n0 = Sn[2 * m], n1 = Sn[2 * m + 1];
                        snb = __builtin_bit_cast(bf16x8, (u32x4){cvt_pk_bf16(n0[0], n0[1]), cvt_pk_bf16(n0[2], n0[3]), cvt_pk_bf16(n1[0], n1[1]), cvt_pk_bf16(n1[2], n1[3])}); }
#pragma unroll
                    for (int it = 0; it < 4; ++it) { const bf16x8 a = __builtin_bit_cast(bf16x8, (u32x4){ql[m & 1][it].x, ql[m & 1][it].y, qh[m & 1][it].x, qh[m & 1][it].y});
                        O2[it] = __builtin_amdgcn_mfma_f32_16x16x32_bf16(a, sb, O2[it], 0, 0, 0);
                        if (ML) O2n[it] = __builtin_amdgcn_mfma_f32_16x16x32_bf16(a, snb, O2n[it], 0, 0, 0); }
                    __builtin_amdgcn_sched_barrier(0);
                }
            }
#pragma unroll
            for (int it = 0; it < 4; ++it) {
                const int i0 = 16 * it + 4 * kg; float o[4];
                if (!ML) {
#pragma unroll
                    for (int r = 0; r < 4; ++r) o[r] = O1[it][r] + __builtin_amdgcn_exp2f((float)(i0 + r + 1) * lg) * O2[it][r];
                } else {
                    const f32x4 wi = *(const LAS f32x4*)(winter + i0), en = *(const LAS f32x4*)(enm + i0);
#pragma unroll
                    for (int r = 0; r < 4; ++r) { const float den = O1n[it][r] + wi[r] * O2n[it][r];
                        o[r] = (O1[it][r] + wi[r] * O2[it][r]) / fmaxf(fabsf(den), en[r]); }
                }
#pragma unroll
                for (int r = 0; r < 4; ++r) *(LAS bf16_t*)(lds + O_OB + (i0 + r) * PV + (16 * w + r16) * 2) = (bf16_t)(cvt_pk_bf16(o[r], 0.f) & 0xffffu);
                __builtin_amdgcn_sched_barrier(0);
            }
            const float decay = ML ? gst : __builtin_amdgcn_exp2f(64.0f * lg);
            {
                bf16x8 ka[3][2];
                const LAS unsigned char* kt0 = lds + O_KS + (8 * kg + q4) * PQ + 8 * p4;
#pragma unroll
                for (int d0 = 0; d0 < 2; ++d0)
#pragma unroll
                    for (int ks = 0; ks < 2; ++ks) { const LAS unsigned char* ka_ = kt0 + 32 * ks * PQ + 32 * d0; ka[d0][ks] = cat4(tr_read(ka_), tr_read(ka_ + 4 * PQ)); }
#pragma unroll
                for (int dt = 0; dt < NDT; ++dt) {
                    if (dt + 2 < NDT) {
#pragma unroll
                        for (int ks = 0; ks < 2; ++ks) { const LAS unsigned char* ka_ = kt0 + 32 * ks * PQ + 32 * (dt + 2); ka[(dt + 2) % 3][ks] = cat4(tr_read(ka_), tr_read(ka_ + 4 * PQ)); } }
                    S[dt] = S[dt] * decay;
                    if (ML) Sn[dt] = Sn[dt] * decay;
#pragma unroll
                    for (int ks = 0; ks < 2; ++ks) { S[dt] = __builtin_amdgcn_mfma_f32_16x16x32_bf16(ka[dt % 3][ks], bvp[ks], S[dt], 0, 0, 0);
                        if (ML) Sn[dt] = __builtin_amdgcn_mfma_f32_16x16x32_bf16(ka[dt % 3][ks], gkf[ks], Sn[dt], 0, 0, 0); }
                    __builtin_amdgcn_sched_barrier(0);
                }
            }
        }
        BAR_LDS();
        asm volatile("" : "+v"(tv));
#pragma unroll
        for (int i = 0; i < 2; ++i) { const int id = tv + 512 * i, row = id >> 4, pc = id & 15;
            *(u32x4*)(outp + (row0 + c * 64 + row) * DM + ocol + pc * 8) = *(const LAS u32x4*)(lds + O_OB + row * PV + pc * 16); }
        if (c + 1 < NC) stage_chunk();
        BAR_LDS();
    }
}
#ifndef NAIVE_MIX
#define NAIVE_MIX 0
#endif
__device__ __forceinline__ void phase_mix(const Params& p, LAS unsigned char* lds, int bid, int nblk, int sel = 3, int qidx = 0) {
#if NAIVE_MIX
    if (bid < 32) retention_naive(p, lds, bid >> 2, bid & 3);
    else if (bid < 64) mlstm_naive(p, lds, (bid - 32) >> 2, (bid - 32) & 3);
#else
    if ((bid & 1) == 0 && bid < 256) { const int cid = bid >> 1;
        float* gscr = (float*)(p.ws + WS_BINTOK) + (size_t)cid * 32768;
        if (cid < 64) { if (sel & 1) chain_mfma<256, false>(p, lds, cid >> 3, (cid >> 1) & 3, cid & 1, gscr); }
        else { if (sel & 2) chain_mfma<128, true>(p, lds, (cid - 64) >> 3, ((cid - 64) >> 1) & 3, cid & 1, gscr); } }
#endif
    else if (sel == 3 && qidx == 0) {
        pg8::SchedDense S{T / 256, 4, nblk / 2, bid >> 1, (const char*)(p.ws + WS_WIN), DM * 2, INWM / 256 - 4}; pg8::EpiProj E{(bf16_t*)(p.ws + WS_RB)};
        pg8::gemm_phase<false, CFG_P2>(lds, (const char*)(p.ws + WS_U1B), DM * 2, S, E, p.ws + WS_DUMMY);
    }
    __syncthreads();
    expert_convert(p, lds, qidx);
}

__device__ __forceinline__ void phase_headnorm(const Params& p, LAS unsigned char* lds, int bid, int nblk) {
    const int tid = threadIdx.x, lane = tid & 63, wave = __builtin_amdgcn_readfirstlane(tid >> 6);
    const bf16_t* raw = (const bf16_t*)(p.ws + WS_RC); const bf16_t* proj = (const bf16_t*)(p.ws + WS_RB); bf16_t* mixed = (bf16_t*)(p.ws + WS_RA);
    LAS float* vnw = (LAS float*)lds;
    for (int i = tid; i < DM; i += NTHREADS) vnw[i] = (i < 1024) ? p.ret_norm_w[i] : p.ml_norm_w[i - 1024];
    __syncthreads();
    const int rpb = T / nblk;
    for (int r0 = bid * rpb + 2 * wave; r0 < (bid + 1) * rpb; r0 += 2 * NWAVES) {
        u32x4 rvq[2][4], gvq[2][4];
#pragma unroll
        for (int q2 = 0; q2 < 2; ++q2)
#pragma unroll
            for (int j = 0; j < 4; ++j) { const int col = 512 * j + 8 * lane; const int gcol = (j < 2) ? (PC_RG + col) : (PC_MO + col - 1024);
                rvq[q2][j] = __builtin_nontemporal_load((const u32x4*)(raw + (size_t)(r0 + q2) * DM + col)); gvq[q2][j] = __builtin_nontemporal_load((const u32x4*)(proj + (size_t)(r0 + q2) * INWM + gcol)); }
#pragma unroll
        for (int q2 = 0; q2 < 2; ++q2)
#pragma unroll
        for (int j = 0; j < 4; ++j) {
            const int r = r0 + q2;
            const int col = 512 * j + 8 * lane;
            const u32x4 rv = rvq[q2][j];
            const u32x4 gv = gvq[q2][j];
            const f32x4 w0 = *(const LAS f32x4*)(vnw + col), w1 = *(const LAS f32x4*)(vnw + col + 4);
            float x[8] = {bf_lo(rv.x), bf_hi(rv.x), bf_lo(rv.y), bf_hi(rv.y), bf_lo(rv.z), bf_hi(rv.z), bf_lo(rv.w), bf_hi(rv.w)};
            float gt[8] = {bf_lo(gv.x), bf_hi(gv.x), bf_lo(gv.y), bf_hi(gv.y), bf_lo(gv.z), bf_hi(gv.z), bf_lo(gv.w), bf_hi(gv.w)};
            float s = 0.f;
#pragma unroll
            for (int q = 0; q < 8; ++q) s += x[q];
            const float mean = half_sum(s) * (1.0f / 256.0f); float s2 = 0.f;
#pragma unroll
            for (int q = 0; q < 8; ++q) { x[q] -= mean; s2 += x[q] * x[q]; }
            const float rstd = 1.0f / sqrtf(half_sum(s2) * (1.0f / 256.0f) + GN_EPS);
            float o[8];
#pragma unroll
            for (int q = 0; q < 8; ++q) { const float wq = (q < 4) ? w0[q & 3] : w1[q & 3]; const float gg = (j < 2) ? fsilu(gt[q]) : fsigmoid(gt[q]); o[q] = x[q] * rstd * wq * gg; }
            *(u32x4*)(mixed + (size_t)r * DM + col) = (u32x4){cvt_pk_bf16(o[0], o[1]), cvt_pk_bf16(o[2], o[3]), cvt_pk_bf16(o[4], o[5]), cvt_pk_bf16(o[6], o[7])};
        }
    }
}

constexpr int PA = 4112;
constexpr int R_AHI = 0, R_ALO = 16 * PA, R_P = 32 * PA, R_LIST = R_P + 8192, R_LCNT = R_LIST + 4096, R_LBASE = R_LCNT + 256;
static_assert(R_LBASE + 256 <= BARW_OFF, "router LDS map");
__device__ __forceinline__ void phase_router(const Params& p, LAS unsigned char* lds, int bid, int nblk, int dry = 0) {
    const int tid = threadIdx.x, lane = tid & 63, wave = __builtin_amdgcn_readfirstlane(tid >> 6);
    unsigned char* ws = p.ws;
    const float* mod = (const float*)(ws + WS_MOD); const bf16_t* mix = (const bf16_t*)(ws + WS_RC);
    unsigned char* U8 = ws + WS_U2; float* wts = (float*)(ws + WS_WTS); unsigned* pos = (unsigned*)(ws + WS_POS);
    int* bin_tok = (int*)(ws + WS_BINTOK); unsigned* count = (unsigned*)(ws + WS_CTL) + CW_CNT + (dry ? 128 : 0);
    const bool do1 = !dry || (dry & 1), do2 = !dry || (dry & 2), do3 = !dry || (dry & 4);
    const bf16_t* WRH = (const bf16_t*)(ws + WS_WRHI); const bf16_t* WRL = (const bf16_t*)(ws + WS_WRLO);
    LAS float* P = (LAS float*)(lds + R_P);
    LAS unsigned* list = (LAS unsigned*)(lds + R_LIST);
    LAS unsigned* lcnt = (LAS unsigned*)(lds + R_LCNT); LAS unsigned* lbase = (LAS unsigned*)(lds + R_LBASE);
    const int tpb = T / nblk;
    const int tok0 = bid * tpb, b = tok0 / SEQ;
    if (tid < 64) lcnt[tid] = 0u;
    LAS float* vg1 = (LAS float*)(lds + R_ALO); LAS float* vlg = vg1 + DM; LAS float* vlb = vlg + DM; LAS float* vsc = vlb + DM; LAS float* vsh = vsc + DM;
    for (int i = tid; i < DM; i += NTHREADS) { vg1[i] = mod[b * MODW + 2 * DM + i]; vlg[i] = p.ln1_g[i]; vlb[i] = p.ln1_b[i]; vsc[i] = 1.0f + mod[b * MODW + 4 * DM + i]; vsh[i] = mod[b * MODW + 3 * DM + i]; }
    __syncthreads();
    const float ebias = p.e_bias[lane];
    bf16x8 wres[16];
    { const int nt_ = wave & 3, kh_ = wave >> 2; const bf16_t* bh_ = WRH + ((size_t)((kh_ * 4 + nt_) * 32) * 64 + lane) * 8;
#pragma unroll
      for (int s = 0; s < 16; ++s) wres[s] = *(const bf16x8*)(bh_ + 512 * (16 + s)); }
    for (int it = 0; it < tpb / 16; ++it) {
        if (do1)
#pragma unroll
        for (int q = 0; q < 2; ++q) {
            const int tl = 2 * wave + q, t = tok0 + it * 16 + tl;
            const f32x4* xr = (const f32x4*)(p.x + (size_t)t * DM) + lane; const u32x2* mr = (const u32x2*)(mix + (size_t)t * DM) + lane;
            f32x4 v[8]; float s = 0.f;
#pragma unroll
            for (int j = 0; j < 8; ++j) { const f32x4 xv = __builtin_nontemporal_load(xr + 64 * j); const u32x2 mv = __builtin_nontemporal_load(mr + 64 * j); const f32x4 g = *((const LAS f32x4*)vg1 + lane + 64 * j);
                v[j] = xv * DN_ALPHA + g * (f32x4){bf_lo(mv.x), bf_hi(mv.x), bf_lo(mv.y), bf_hi(mv.y)};
                s += (v[j][0] + v[j][1]) + (v[j][2] + v[j][3]); }
            const float mean = wave_sum(s) * (1.0f / DM); float s2 = 0.f;
#pragma unroll
            for (int j = 0; j < 8; ++j) { v[j] = v[j] - mean; s2 += (v[j][0] * v[j][0] + v[j][1] * v[j][1]) + (v[j][2] * v[j][2] + v[j][3] * v[j][3]); }
            const float rstd = 1.0f / sqrtf(wave_sum(s2) * (1.0f / DM) + LN_EPS);
            u32x2* orow = (u32x2*)(ws + WS_X1B + (size_t)t * DM * 2) + lane; unsigned* urow = (unsigned*)(U8 + (size_t)t * DM) + lane;
#pragma unroll
            for (int j = 0; j < 8; ++j) {
                const f32x4 lg = *((const LAS f32x4*)vlg + lane + 64 * j), lb = *((const LAS f32x4*)vlb + lane + 64 * j);
                const f32x4 x1 = v[j] * rstd * lg + lb;
                { const f32x4 xa = x1 * DN_ALPHA; orow[64 * j] = (u32x2){cvt_pk_bf16(xa[0], xa[1]), cvt_pk_bf16(xa[2], xa[3])}; }
                const f32x4 sc = *((const LAS f32x4*)vsc + lane + 64 * j), sh = *((const LAS f32x4*)vsh + lane + 64 * j);
                const f32x4 u = x1 * sc + sh;
                const unsigned h0 = cvt_pk_bf16(u[0], u[1]), h1 = cvt_pk_bf16(u[2], u[3]);
                { int d8 = 0; d8 = __builtin_amdgcn_cvt_pk_fp8_f32(u[0], u[1], d8, false); d8 = __builtin_amdgcn_cvt_pk_fp8_f32(u[2], u[3], d8, true); urow[64 * j] = (unsigned)d8; }
                *(LAS u32x2*)(lds + R_AHI + tl * PA + (4 * lane + 256 * j) * 2) = (u32x2){h0, h1};
            }
        }
        __syncthreads();
        if (do2) {
            const int nt = wave & 3, kh = wave >> 2, fr = lane & 15, fq = lane >> 4;
            f32x4 acc = (f32x4){0.f, 0.f, 0.f, 0.f}, acc2 = acc;
            const bf16_t* bh = WRH + ((size_t)((kh * 4 + nt) * 32) * 64 + lane) * 8; const bf16_t* bl = WRL + ((size_t)((kh * 4 + nt) * 32) * 64 + lane) * 8;
            const LAS unsigned char* ah = lds + R_AHI + fr * PA + (kh * 1024 + 8 * fq) * 2;
#pragma unroll 4
            for (int s = 0; s < 16; ++s) {
                const bf16x8 bhi = *(const bf16x8*)(bh + 512 * s);
                const bf16x8 ahi = *(const LAS bf16x8*)(ah + 64 * s);
                if (s & 1) acc2 = __builtin_amdgcn_mfma_f32_16x16x32_bf16(ahi, bhi, acc2, 0, 0, 0); else acc = __builtin_amdgcn_mfma_f32_16x16x32_bf16(ahi, bhi, acc, 0, 0, 0);
            }
#pragma unroll
            for (int s = 16; s < 32; ++s) {
                const bf16x8 ahi = *(const LAS bf16x8*)(ah + 64 * s);
                if (s & 1) acc2 = __builtin_amdgcn_mfma_f32_16x16x32_bf16(ahi, wres[s - 16], acc2, 0, 0, 0); else acc = __builtin_amdgcn_mfma_f32_16x16x32_bf16(ahi, wres[s - 16], acc, 0, 0, 0);
            }
#pragma unroll
            for (int r = 0; r < 4; ++r) P[(kh * 16 + 4 * fq + r) * 64 + 16 * nt + fr] = acc[r] + acc2[r];
        }
        __syncthreads();
        if (do3)
#pragma unroll
        for (int q = 0; q < 2; ++q) {
            const int tl = 2 * wave + q, tloc = it * 16 + tl, t = tok0 + tloc;
            const float logit = P[tl * 64 + lane] + P[(16 + tl) * 64 + lane];
            const float score = 1.0f / (1.0f + __expf(-logit));
            const float bs = score + ebias;
            const unsigned key = (__float_as_uint(bs + 1.0f) & ~63u) | (unsigned)(63 - lane);
            int rk = 0;
#pragma unroll
            for (int x = 1; x < 8; ++x) rk += (__shfl_xor(key, x) > key) ? 1 : 0;
            float gs = (rk < 2) ? bs : 0.f;
            gs += __shfl_xor(gs, 1); gs += __shfl_xor(gs, 2); gs += __shfl_xor(gs, 4);
            const unsigned gkey = (__float_as_uint(gs + 2.0f) & ~7u) | (unsigned)(7 - (lane >> 3));
            int grk = 0;
#pragma unroll
            for (int x = 1; x < 8; ++x) grk += (__shfl_xor(gkey, 8 * x) > gkey) ? 1 : 0;
            const unsigned mkey = (grk < 4) ? key : 0u;
            int erk = 0;
#pragma unroll
            for (int j = 0; j < 64; ++j) erk += ((unsigned)__builtin_amdgcn_readlane((int)mkey, j) > mkey) ? 1 : 0;
            const bool sel = erk < 8;
            const float wsum = wave_sum(sel ? score : 0.f);
            if (sel) {
                const unsigned lr = __hip_atomic_fetch_add(&lcnt[lane], 1u, __ATOMIC_RELAXED, __HIP_MEMORY_SCOPE_WORKGROUP);
                list[tloc * 8 + erk] = ((unsigned)lane << 16) | lr;
                wts[(size_t)t * 8 + erk] = score / wsum * 2.5f;
            }
        }
    }
    __syncthreads();
    if (!do3) return;
    if (tid < 64) lbase[tid] = __hip_atomic_fetch_add(count + tid, lcnt[tid], __ATOMIC_RELAXED, __HIP_MEMORY_SCOPE_AGENT);
    __syncthreads();
    for (int i = tid; i < tpb * 8; i += NTHREADS) { const unsigned v = list[i]; const unsigned e = v >> 16, slot = lbase[e] + (v & 0xffffu); const int t = tok0 + (i >> 3);
        bin_tok[e * 32768 + slot] = t; pos[(size_t)t * 8 + (i & 7)] = (e << 16) | slot; }
}

__device__ __forceinline__ void moe_tables(const Params& p, LAS unsigned char* lds, int& NRT) {
    LAS int* tstart = (LAS int*)(lds + TAB_OFF); LAS int* cstart = tstart + 128; LAS int* cnt = cstart + 128; LAS int* tile_e = cnt + 128;
    const unsigned* count = (const unsigned*)(p.ws + WS_CTL) + CW_CNT;
    const int tid = threadIdx.x;
    if (tid < 64) {
        const int c = (int)count[tid]; const int ntile = (c + 255) >> 8;
        int ps = ntile, pc = c;
#pragma unroll
        for (int o = 1; o < 64; o <<= 1) { const int a = __shfl_up(ps, o), b2 = __shfl_up(pc, o); if (tid >= o) { ps += a; pc += b2; } }
        tstart[tid] = ps - ntile; cstart[tid] = pc - c; cnt[tid] = c;
        if (tid == 63) { tstart[64] = ps; cstart[64] = pc; cnt[64] = T; tstart[65] = ps + T / 256; cstart[65] = pc + T; }
    }
    __syncthreads();
    NRT = tstart[65];
    for (int e = tid >> 3; e < 65; e += NTHREADS / 8) { const int t0 = tstart[e], t1 = tstart[e + 1]; for (int j = t0 + (tid & 7); j < t1; j += 8) tile_e[j] = e; }
    __syncthreads();
}

__device__ __forceinline__ void phase_final(const Params& p, LAS unsigned char* lds, int bid, int nblk, int dry = 0) {
    const int tid = threadIdx.x, lane = tid & 63, wave = __builtin_amdgcn_readfirstlane(tid >> 6);
    int NRT; moe_tables(p, lds, NRT);
    LAS const int* tstart = (LAS const int*)(lds + TAB_OFF);
    const float* mod = (const float*)(p.ws + WS_MOD); const unsigned char* O = p.ws + WS_O;
    const unsigned* pos = (const unsigned*)(p.ws + WS_POS); const float* wts = (const float*)(p.ws + WS_WTS);
    const int tpb = T / nblk;
    for (int t = bid * tpb + wave; t < (bid + 1) * tpb; t += NWAVES) {
        const int b = t / SEQ; const float* g2 = mod + b * MODW + 5 * DM;
        f32x4 a[8];
#pragma unroll
        for (int j = 0; j < 8; ++j) a[j] = (f32x4){0.f, 0.f, 0.f, 0.f};
#pragma unroll
        for (int k = 0; k < 9; ++k) {
            int crow; float w;
            if (k < 8) { const unsigned pv = pos[(size_t)t * 8 + k]; crow = 256 * tstart[pv >> 16] + (int)(pv & 0xffffu); w = wts[(size_t)t * 8 + k] * 0.25f; }
            else { crow = 256 * tstart[64] + t; w = 0.25f; }
            const unsigned* orow8 = (const unsigned*)(O + (size_t)crow * DM) + lane;
#pragma unroll
            for (int j = 0; j < 8; ++j) { const unsigned ov = __builtin_nontemporal_load(orow8 + 64 * j);
                const f32x2 e0 = __builtin_amdgcn_cvt_pk_f32_fp8((int)ov, false), e1 = __builtin_amdgcn_cvt_pk_f32_fp8((int)ov, true);
                a[j] += (f32x4){e0[0], e0[1], e1[0], e1[1]} * w; }
        }
        float* orow = (dry ? (float*)(p.ws + WS_RB) : p.out) + (size_t)t * DM;
        const u32x2* xrow = (const u32x2*)(p.ws + WS_X1B + (size_t)t * DM * 2) + lane;
        f32x4 v[8]; float s = 0.f;
#pragma unroll
        for (int j = 0; j < 8; ++j) { const f32x4 g = *((const f32x4*)g2 + lane + 64 * j); const u32x2 xb = __builtin_nontemporal_load(xrow + 64 * j); const f32x4 d = (f32x4){bf_lo(xb.x), bf_hi(xb.x), bf_lo(xb.y), bf_hi(xb.y)} + g * a[j];
            v[j] = d; s += (d[0] + d[1]) + (d[2] + d[3]); }
        const float mean = wave_sum(s) * (1.0f / DM); float s2 = 0.f;
#pragma unroll
        for (int j = 0; j < 8; ++j) { const f32x4 d = v[j] - mean; v[j] = d; s2 += (d[0] * d[0] + d[1] * d[1]) + (d[2] * d[2] + d[3] * d[3]); }
        const float rstd = 1.0f / sqrtf(wave_sum(s2) * (1.0f / DM) + LN_EPS);
#pragma unroll
        for (int j = 0; j < 8; ++j) { const f32x4 lg = *((const f32x4*)p.ln2_g + lane + 64 * j), lb = *((const f32x4*)p.ln2_b + lane + 64 * j);
            *((f32x4*)orow + lane + 64 * j) = v[j] * rstd * lg + lb; }
    }
}

__global__ void __launch_bounds__(NTHREADS, 2) mega(Params p) {
    extern __shared__ __attribute__((aligned(16))) unsigned char lds_raw[];
    LAS unsigned char* lds = (LAS unsigned char*)lds_raw;
    const int bid = blockIdx.x, nblk = gridDim.x, tid = threadIdx.x;
    volatile LAS unsigned* barw = (volatile LAS unsigned*)(lds + BARW_OFF);
    if (tid < 4) barw[tid] = 0u;
    __syncthreads();
    unsigned* ctl = (unsigned*)(p.ws + WS_CTL);
    const int lo = p.ph_lo, hi = p.ph_hi;
    XcdBarrier bar; bar.bar = ctl + CW_BAR; bar.x = 0; bar.st = barw;
    if (hi - lo > 1) bar = xcd_barrier_post(ctl + CW_BAR, barw);
#ifndef PH_MASK
#define PH_MASK 0x7FF
#endif
#define IN(k) (((PH_MASK >> (k)) & 1) && lo <= (k) && (k) < hi)
#define SEAM(k) do { if (IN(k) && IN((k) + 1)) xcd_barrier(bar); } while (0)
    unsigned char* ws = p.ws;
#ifndef DUP_MASK
#define DUP_MASK 0
#endif
#ifndef DRY_STEPS
#define DRY_STEPS 7
#endif
#ifndef DUP_SEL
#define DUP_SEL 3
#endif
#ifndef DUP_Q
#define DUP_Q 0
#endif
#define DUPK(k) (((DUP_MASK) >> (k)) & 1)
#define P2BODY { pg8::SchedDense S{T / 256, INWM / 256 - 4, nblk, bid, (const char*)(ws + WS_WIN), DM * 2, 0}; pg8::EpiProj E{(bf16_t*)(ws + WS_RB)}; pg8::gemm_phase<false, CFG_P2>(lds, (const char*)(ws + WS_RA), DM * 2, S, E, ws + WS_DUMMY); }
#define P5BODY { pg8::SchedDense S{T / 256, DM / 256, nblk, bid, (const char*)(ws + WS_WOUT), DM * 2, 0}; pg8::EpiPlain E{(bf16_t*)(ws + WS_RC), DM, 1.0f}; pg8::gemm_phase<false, CFG_P6>(lds, (const char*)(ws + WS_RA), DM * 2, S, E, ws + WS_DUMMY); }
#define P7BODY { int NRT; moe_tables(p, lds, NRT); \
        pg8::SchedMoE S{tab, tab + 128, tab + 256, tab + 384, NRT, 4, 0, nblk, bid, (const char*)(ws + WS_WGU), (size_t)1024 * DM, DM, 1, (const int*)(ws + WS_BINTOK)}; \
        pg8::EpiSwiGLU8 E{ws + WS_H}; pg8::gemm_phase<true, CFG_P8>(lds, (const char*)(ws + WS_U2), DM, S, E, ws + WS_DUMMY); }
#define P8BODY(pnoff) { int NRT; moe_tables(p, lds, NRT); \
        pg8::SchedMoE S{tab, tab + 128, tab + 256, tab + 384, NRT, 8, pnoff, nblk, bid, (const char*)(ws + WS_WD), (size_t)DM * FE, FE, 0, nullptr}; \
        pg8::EpiPlain8 E{ws + WS_O, DM, 0.0625f}; pg8::gemm_phase<true, CFG_P9>(lds, (const char*)(ws + WS_H), FE, S, E, ws + WS_DUMMY); }
    LAS const int* tab = (LAS const int*)(lds + TAB_OFF);
    if (IN(0)) { phase_prologue(p, lds, bid, nblk); if (DUPK(0)) { __syncthreads(); phase_prologue(p, lds, bid, nblk); } } SEAM(0);
    if (IN(1)) { phase_modulate(p, lds, bid, nblk); if (DUPK(1)) { __syncthreads(); phase_modulate(p, lds, bid, nblk); } } SEAM(1);
    if (IN(2)) { P2BODY if (DUPK(2)) P2BODY } SEAM(2);
    if (IN(3)) { phase_conv(p, lds, bid, nblk); } SEAM(3);
    if (IN(4)) { phase_mix(p, lds, bid, nblk); if (DUPK(4)) { __syncthreads(); phase_mix(p, lds, bid, nblk, DUP_SEL, DUP_Q); } } SEAM(4);
    if (IN(5)) { phase_headnorm(p, lds, bid, nblk); if (DUPK(5)) phase_headnorm(p, lds, bid, nblk); } SEAM(5);
    if (IN(6)) { P5BODY if (DUPK(6)) P5BODY } SEAM(6);
    if (IN(7)) { if (DUPK(7)) { phase_router(p, lds, bid, nblk, DRY_STEPS); __syncthreads(); } phase_router(p, lds, bid, nblk); } SEAM(7);
    if (IN(8)) { P7BODY if (DUPK(8)) P7BODY } SEAM(8);
    if (IN(9)) { P8BODY(0) if (DUPK(9)) P8BODY(0) } SEAM(9);
    if (IN(10)) { for (int rep_ = DUPK(10) ? 1 : 0; rep_ >= 0; --rep_) { phase_final(p, lds, bid, nblk, rep_); __syncthreads(); } }
#undef IN
#undef SEAM
}

constexpr int NPHASES = 11;
extern "C" void kernel_launch(void* const* d_in, const int* in_sizes, int n_in, void* d_out, int out_size, void* d_ws, size_t ws_size, hipStream_t stream) {
    static int grid = 0;
    if (grid == 0) {
        if (n_in != 23 || in_sizes[0] != T * DM || out_size != T * DM || ws_size < WS_END) { fprintf(stderr, "kernel_launch: unexpected shapes / workspace (%d inputs, ws %zu, need %zu)\n", n_in, ws_size, (size_t)WS_END); grid = -1; return; }
        if (hipFuncSetAttribute((const void*)mega, hipFuncAttributeMaxDynamicSharedMemorySize, LDS_BYTES) != hipSuccess) { fprintf(stderr, "kernel_launch: hipFuncSetAttribute failed\n"); grid = -1; return; }
        int dev = 0, cus = 0, per_cu = 0;
        hipGetDevice(&dev); hipDeviceGetAttribute(&cus, hipDeviceAttributeMultiprocessorCount, dev);
        if (hipOccupancyMaxActiveBlocksPerMultiprocessor(&per_cu, (const void*)mega, NTHREADS, LDS_BYTES) != hipSuccess || per_cu < 1) fprintf(stderr, "kernel_launch: occupancy query says %d\n", per_cu);
        (void)hipGetLastError();
        grid = 256;
        if (cus != 256) fprintf(stderr, "kernel_launch: device has %d CUs; this kernel is built for a resident grid of 256 workgroups\n", cus);
    }
    if (grid < 0) return;
    hipMemsetAsync((char*)d_ws + WS_CTL, 0, CTL_BYTES, stream);
    Params p{};
    const float** f = (const float**)&p;
    for (int i = 0; i < 23; ++i) f[i] = (const float*)d_in[i];
    p.out = (float*)d_out; p.ws = (unsigned char*)d_ws;
#ifndef N_LAUNCHES
#define N_LAUNCHES 1
#endif
    if (N_LAUNCHES == 1) { p.ph_lo = 0; p.ph_hi = NPHASES; hipLaunchKernelGGL(mega, dim3(grid), dim3(NTHREADS), LDS_BYTES, stream, p); }
    else for (int ph = 0; ph < NPHASES; ++ph) {
        p.ph_lo = ph; p.ph_hi = ph + 1;
        hipLaunchKernelGGL(mega, dim3(grid), dim3(NTHREADS), LDS_BYTES, stream, p);
    }
}
```

```cpp
#include <hip/hip_runtime.h>
#include <cstdio>
#include <cstdint>

#define LAS __attribute__((address_space(3)))
typedef unsigned short bf16_t;
typedef short bf16x8 __attribute__((ext_vector_type(8)));
typedef float f32x4 __attribute__((ext_vector_type(4)));
typedef float f32x2 __attribute__((ext_vector_type(2)));
typedef unsigned u32x4 __attribute__((ext_vector_type(4)));
typedef unsigned u32x2 __attribute__((ext_vector_type(2)));
typedef int i32x4 __attribute__((ext_vector_type(4)));
typedef int i32x8 __attribute__((ext_vector_type(8)));

constexpr int DM = 2048, NBATCH = 8, SEQ = 4096, T = NBATCH * SEQ;
constexpr int INW = 7176, INWM = 7168;
constexpr int NE = 64, FE = 512;
constexpr int MODW = 6 * DM;
constexpr float DN_ALPHA = 1.189207115002721f;
constexpr float LN_EPS = 1e-5f, GN_EPS = 1e-6f;
constexpr int NTHREADS = 512, NWAVES = 8;
constexpr int PC_RQ = 0, PC_RK = 1024, PC_RV = 2048, PC_RG = 3072, PC_MQK = 4096, PC_MV = 5120, PC_MO = 6144;

constexpr size_t MiB = 1u << 20;
constexpr size_t WS_CTL = 0, CTL_BYTES = 1 * MiB;
constexpr size_t WS_MOD = 1 * MiB;
constexpr size_t WS_GATEW = 1 * MiB + 512 * 1024;
constexpr size_t WS_GATES = 2 * MiB;
constexpr size_t WS_WRHI = 3 * MiB, WS_WRLO = 3 * MiB + 256 * 1024;
constexpr size_t WS_POS = 4 * MiB;
constexpr size_t WS_WTS = 5 * MiB;
constexpr size_t WS_BINTOK = 8 * MiB;
constexpr size_t WS_WIN = 24 * MiB;
constexpr size_t WS_WOUT = 52 * MiB;
constexpr size_t WS_WD = 60 * MiB;
constexpr size_t WS_WGU = 190 * MiB;
constexpr size_t WS_RA = 450 * MiB;
constexpr size_t WS_U1B = WS_RA;
constexpr size_t WS_CONV = 320 * MiB;
constexpr size_t WS_RC = 578 * MiB;
constexpr size_t WS_RB = 706 * MiB;
constexpr size_t WS_U2 = WS_RB, WS_H = WS_RB + 128 * MiB;
constexpr size_t WS_O = 190 * MiB;
constexpr size_t WS_X1B = 990 * MiB;
constexpr size_t WS_DUMMY = 1118 * MiB;
constexpr size_t WS_END = 1154 * MiB;
static_assert(WS_O + (size_t)311296 * 1024 * 2 <= WS_H, "o overlay");
static_assert(WS_H + (size_t)311296 * 1024 <= WS_END, "h");
constexpr int CW_BAR = 4096, CW_CNT = 8192, CW_QUEUE = 8192 + 256;

constexpr int RING_BYTES = 131072;
constexpr int TAB_OFF = 131072;
constexpr int LDS_BYTES = 147456;
constexpr int BARW_OFF = LDS_BYTES - 64;

struct Params {
    const float *x, *c, *w_ada, *b_ada, *w_in, *b_gates, *conv_w, *conv_b, *ret_norm_w, *ml_norm_w, *w_out, *ln1_g, *ln1_b,
                *w_router, *e_bias, *w_gate, *w_up, *w_down, *ws_gate, *ws_up, *ws_down, *ln2_g, *ln2_b;
    float* out; unsigned char* ws; int ph_lo, ph_hi;
};

__device__ __forceinline__ unsigned cvt_pk_bf16(float lo, float hi) { unsigned r; asm("v_cvt_pk_bf16_f32 %0, %1, %2" : "=v"(r) : "v"(lo), "v"(hi)); return r; }
__device__ __forceinline__ float bf_lo(unsigned w) { return __uint_as_float(w << 16); }
__device__ __forceinline__ float bf_hi(unsigned w) { return __uint_as_float(w & 0xffff0000u); }
__device__ __forceinline__ float bf2f(bf16_t b) { return __uint_as_float(((unsigned)b) << 16); }
#define DPPF(v, ctrl) __builtin_bit_cast(float, __builtin_amdgcn_update_dpp(0, __builtin_bit_cast(int, (v)), (ctrl), 0xF, 0xF, true))
__device__ __forceinline__ float row_sum16(float v) {
    v += DPPF(v, 0xB1);
    v += DPPF(v, 0x4E);
    v += DPPF(v, 0x141);
    v += DPPF(v, 0x140);
    return v;
}
__device__ __forceinline__ float rl(float v, int l) { return __builtin_bit_cast(float, __builtin_amdgcn_readlane(__builtin_bit_cast(int, v), l)); }
__device__ __forceinline__ float wave_sum(float v) { const float r = row_sum16(v); return (rl(r, 0) + rl(r, 16)) + (rl(r, 32) + rl(r, 48)); }
__device__ __forceinline__ float half_sum(float v) {
    const float r = row_sum16(v); const float lo = rl(r, 0) + rl(r, 16), hi = rl(r, 32) + rl(r, 48);
    return (threadIdx.x & 32) ? hi : lo;
}
__device__ __forceinline__ float fsilu(float x) { return x * __builtin_amdgcn_rcpf(1.0f + __builtin_amdgcn_exp2f(-1.4426950408889634f * x)); }
__device__ __forceinline__ float fsigmoid(float x) { return __builtin_amdgcn_rcpf(1.0f + __builtin_amdgcn_exp2f(-1.4426950408889634f * x)); }
#define LDS_WAIT() asm volatile("s_waitcnt lgkmcnt(0)" ::: "memory")

#define XB_TMO      128
#define XB_XCNT(j)  (256  + 64 * (j))
#define XB_XSUB(j)  (1280 + 64 * (j))
#define XB_XGEN(j)  (2304 + 64 * (j))
#define XB_TOP      3328
#define XB_TOPGEN   3392
#define XCD_BAR_WORDS 3456
#define XB_SPIN_CAP (1u << 18)
__device__ __forceinline__ unsigned xb_ld(unsigned* p)              { return __hip_atomic_load(p, __ATOMIC_RELAXED, __HIP_MEMORY_SCOPE_AGENT); }
__device__ __forceinline__ unsigned xb_add(unsigned* p, unsigned v) { return __hip_atomic_fetch_add(p, v, __ATOMIC_RELAXED, __HIP_MEMORY_SCOPE_AGENT); }
__device__ __forceinline__ unsigned xb_xcc_id() { return (unsigned)__builtin_amdgcn_s_getreg((3 << 11) | 20) & 0xFu; }
#define XB_SPIN(cond, bar) do { unsigned _sp = 0; while (cond) { __builtin_amdgcn_s_sleep(1); \
    if ((++_sp & 255u) == 0u) { if (xb_ld(&(bar)[XB_TMO])) break; if (_sp > XB_SPIN_CAP) { atomicAdd(&(bar)[XB_TMO], 1u); break; } } } } while (0)
struct XcdBarrier { unsigned* bar; unsigned x; volatile LAS unsigned* st; };
__device__ __forceinline__ XcdBarrier xcd_barrier_post(unsigned* bar, volatile LAS unsigned* st) {
    XcdBarrier b; b.bar = bar; b.x = xb_xcc_id(); b.st = st;
    if (threadIdx.x == 0) (void)xb_add(&bar[XB_XCNT(b.x)], 1u);
    return b;
}
__device__ __forceinline__ void xcd_barrier_complete(unsigned* bar, unsigned x, unsigned& nloc, unsigned& nx) {
    const unsigned G = gridDim.x * gridDim.y * gridDim.z;
    unsigned sum, cnt, mine, sp = 0u;
    for (;;) {
        sum = 0u; cnt = 0u; mine = 0u;
#pragma unroll
        for (unsigned j = 0; j < 16; ++j) { const unsigned c = xb_ld(&bar[XB_XCNT(j)]); sum += c; cnt += (c > 0u) ? 1u : 0u; mine = (j == x) ? c : mine; }
        if (sum == G) break;
        __builtin_amdgcn_s_sleep(1);
        if ((++sp & 255u) == 0u) { if (xb_ld(&bar[XB_TMO])) break; if (sp > XB_SPIN_CAP) { atomicAdd(&bar[XB_TMO], 1u); break; } }
    }
    nloc = mine > 0u ? mine : 1u; nx = cnt > 0u ? cnt : 1u;
}
__device__ __forceinline__ void xcd_barrier(const XcdBarrier& b) {
    asm volatile("s_waitcnt vmcnt(0)" ::: "memory");
    __syncthreads();
    if (threadIdx.x == 0) {
        unsigned* bar = b.bar;
        __builtin_amdgcn_s_waitcnt(0);
        unsigned nloc = b.st[0], nx = b.st[1];
        if (nloc == 0u) { xcd_barrier_complete(bar, b.x, nloc, nx); b.st[0] = nloc; b.st[1] = nx; }
        const unsigned old = xb_add(&bar[XB_XSUB(b.x)], 1u);
        const unsigned gen = old / nloc;
        if (old + 1u == (gen + 1u) * nloc) {
            __builtin_amdgcn_fence(__ATOMIC_RELEASE, "agent");
            asm volatile("s_waitcnt vmcnt(0)" ::: "memory");
            const unsigned og = xb_add(&bar[XB_TOP], 1u);
            const unsigned tg = og / nx;
            if (og + 1u == (tg + 1u) * nx) xb_add(&bar[XB_TOPGEN], 1u);
            else XB_SPIN(xb_ld(&bar[XB_TOPGEN]) == tg, bar);
            __builtin_amdgcn_fence(__ATOMIC_ACQUIRE, "agent");
            xb_add(&bar[XB_XGEN(b.x)], 1u);
            asm volatile("s_waitcnt vmcnt(0)" ::: "memory");
        } else {
            XB_SPIN(xb_ld(&bar[XB_XGEN(b.x)]) == gen, bar);
            __builtin_amdgcn_fence(__ATOMIC_ACQUIRE, "agent");
            asm volatile("s_waitcnt vmcnt(0)" ::: "memory");
        }
    }
    __syncthreads();
}

namespace pg8 {
constexpr int BM = 256, BK = 64, HALF = 128, HTB = HALF * BK * 2, STAGE_BYTES = 8 * HTB, NXCD = 8, WGM = 8;
__host__ __device__ __forceinline__ int lds_byte(int r, int c) { const int st = (r >> 4) * 2 + (c >> 5), rr = r & 15, cc = c & 31, ob = rr * 64 + cc * 2; return st * 1024 + (ob ^ (((ob >> 9) & 1) << 5)); }
__host__ __device__ __forceinline__ void stage_rc(int b, int& R, int& C) { const int st = b / 1024, sb = b % 1024, swz = sb ^ (((sb >> 9) & 1) << 5); R = (st >> 1) * 16 + swz / 64; C = (st & 1) * 32 + (swz % 64) / 2; }
__host__ __device__ __forceinline__ int perm32(int rho) { const int n = rho >> 4, i = rho & 15, fq = i >> 2; return 16 * (fq & 1) + 8 * (fq >> 1) + 4 * n + (i & 3); }

struct Unit { int pm, pn; const char* B; int e, r0, cnt, crow0; };

__device__ __forceinline__ bool order_next(int i, int G, int c, int nM, int nN, int& pm, int& pn) {
    const int nwg = nM * nN; const long L = (long)i * G + c; if (L >= nwg) return false;
    int wgid = (int)L; { const int q = nwg / NXCD, r = nwg % NXCD, xcd = wgid % NXCD, off = wgid / NXCD; wgid = (xcd < r ? xcd * (q + 1) : r * (q + 1) + (xcd - r) * q) + off; }
    const int nig = WGM * nN, gid = wgid / nig, fm = gid * WGM, gsz = (nM - fm) < WGM ? (nM - fm) : WGM;
    pm = fm + ((wgid % nig) % gsz); pn = (wgid % nig) / gsz; return true;
}

struct SchedDense {
    int nM, nN, G, c; const char* Bt; int KB; int pn_off;
    __device__ __forceinline__ bool next(int i, Unit& u) const {
        if (!order_next(i, G, c, nM, nN, u.pm, u.pn)) return false;
        u.pn += pn_off; u.B = Bt + (size_t)u.pn * 256 * KB; u.e = 0; u.r0 = 0; u.cnt = 0; u.crow0 = 0; return true;
    }
    __device__ __forceinline__ void a_rows(const Unit& u, const int (&Rp)[2], int (&ix)[2][2]) const {
#pragma unroll
        for (int h = 0; h < 2; ++h)
#pragma unroll
            for (int i = 0; i < 2; ++i) ix[h][i] = u.pm * 256 + h * 128 + Rp[i];
    }
    __device__ __forceinline__ void settle() const {}
};
struct SchedMoE {
    LAS const int* tstart; LAS const int* cstart; LAS const int* cnt; LAS const int* tile_e;
    int NRT, nN, pn_off, G, c; const char* W; size_t wstride; int KB; int gather; const int* bin_tok;
    __device__ __forceinline__ bool next(int i, Unit& u) const {
        if (!order_next(i, G, c, NRT, nN, u.pm, u.pn)) return false;
        const int e = tile_e[u.pm]; const int j = u.pm - tstart[e];
        u.e = e; u.r0 = 256 * j; u.cnt = cnt[e]; u.crow0 = cstart[e] + 256 * j;
        u.B = W + (size_t)e * wstride + (size_t)(u.pn + pn_off) * 256 * KB; return true;
    }
    __device__ __forceinline__ void a_rows(const Unit& u, const int (&Rp)[2], int (&ix)[2][2]) const {
#pragma unroll
        for (int h = 0; h < 2; ++h)
#pragma unroll
            for (int i = 0; i < 2; ++i) {
                if (gather) { const int slot = u.r0 + h * 128 + Rp[i]; int tok = slot;
                    if (u.e < NE) { const int last = u.cnt - 1; const int* ap = bin_tok + u.e * 32768 + (slot < last ? slot : last);
                        asm volatile("global_load_dword %0, %1, off" : "=v"(tok) : "v"(ap) : "memory"); }
                    ix[h][i] = tok; }
                else ix[h][i] = u.pm * 256 + h * 128 + Rp[i];
            }
    }
    __device__ __forceinline__ void settle() const { if (gather) asm volatile("s_waitcnt vmcnt(0)" ::: "memory"); }
};

struct EpiPlain { static constexpr int PERM = 2; static constexpr int NSTORE = 16; bf16_t* O; int ldc; float sc;
    __device__ __forceinline__ void operator()(const f32x4 (&acc)[2][2][4][2], const Unit& u, int wr, int wc, int fr, int fq) const {
        const int row0 = u.pm * BM + wr * 64 + fr, col0 = u.pn * BM + wc * 64 + 16 * fq;
#pragma unroll
        for (int ai = 0; ai < 2; ++ai)
#pragma unroll
            for (int m = 0; m < 4; ++m) { bf16_t* rowp = O + (size_t)(row0 + ai * HALF + m * 16) * ldc + col0;
#pragma unroll
                for (int bj = 0; bj < 2; ++bj) { const f32x4 v0 = acc[ai][bj][m][0] * sc, v1 = acc[ai][bj][m][1] * sc;
                    u32x4 w; w.x = cvt_pk_bf16(v0[0], v0[1]); w.y = cvt_pk_bf16(v0[2], v0[3]); w.z = cvt_pk_bf16(v1[0], v1[1]); w.w = cvt_pk_bf16(v1[2], v1[3]);
                    *(u32x4*)(rowp + bj * 8) = w; } }
    }
};
struct EpiPlain8 { static constexpr int PERM = 2; static constexpr int NSTORE = 8; unsigned char* O; int ldc; float sc;
    __device__ __forceinline__ void operator()(const f32x4 (&acc)[2][2][4][2], const Unit& u, int wr, int wc, int fr, int fq) const {
        const int row0 = u.pm * BM + wr * 64 + fr, col0 = u.pn * BM + wc * 64 + 16 * fq;
#pragma unroll
        for (int ai = 0; ai < 2; ++ai)
#pragma unroll
            for (int m = 0; m < 4; ++m) { unsigned char* rowp = O + (size_t)(row0 + ai * HALF + m * 16) * ldc + col0; int d[4] = {0, 0, 0, 0};
#pragma unroll
                for (int bj = 0; bj < 2; ++bj) { const f32x4 v0 = acc[ai][bj][m][0] * sc, v1 = acc[ai][bj][m][1] * sc;
                    d[2 * bj] = __builtin_amdgcn_cvt_pk_fp8_f32(v0[0], v0[1], d[2 * bj], false); d[2 * bj] = __builtin_amdgcn_cvt_pk_fp8_f32(v0[2], v0[3], d[2 * bj], true);
                    d[2 * bj + 1] = __builtin_amdgcn_cvt_pk_fp8_f32(v1[0], v1[1], d[2 * bj + 1], false); d[2 * bj + 1] = __builtin_amdgcn_cvt_pk_fp8_f32(v1[2], v1[3], d[2 * bj + 1], true); }
                *(u32x4*)rowp = (u32x4){(unsigned)d[0], (unsigned)d[1], (unsigned)d[2], (unsigned)d[3]}; }
    }
};
struct EpiProj { static constexpr int PERM = 2; static constexpr int NSTORE = 16; bf16_t* O;
    __device__ __forceinline__ void operator()(const f32x4 (&acc)[2][2][4][2], const Unit& u, int wr, int wc, int fr, int fq) const {
        const int row0 = u.pm * BM + wr * 64 + fr, col0 = u.pn * BM + wc * 64 + 16 * fq;
        const bool rot = u.pn < 8; const float ks = (u.pn >= 4 && u.pn < 8) ? 0.0625f : 1.0f;
        float inv[2][2][2];
#pragma unroll
        for (int bj = 0; bj < 2; ++bj)
#pragma unroll
            for (int n = 0; n < 2; ++n)
#pragma unroll
                for (int q = 0; q < 2; ++q) { const int d = 64 * wc + 16 * fq + 8 * bj + 4 * n + 2 * q; inv[bj][n][q] = __builtin_amdgcn_exp2f(-(float)(d >> 1) * 0.10381025296523008f) * 0.15915494309189535f; }
#pragma unroll
        for (int ai = 0; ai < 2; ++ai)
#pragma unroll
            for (int m = 0; m < 4; ++m) { const int row = row0 + ai * HALF + m * 16; const float fs = (float)(row & (SEQ - 1)); bf16_t* rowp = O + (size_t)row * INWM + col0;
#pragma unroll
                for (int bj = 0; bj < 2; ++bj) { f32x4 v[2] = {acc[ai][bj][m][0], acc[ai][bj][m][1]};
                    if (rot) {
#pragma unroll
                        for (int n = 0; n < 2; ++n)
#pragma unroll
                            for (int q = 0; q < 2; ++q) { float t = fs * inv[bj][n][q]; t = t - floorf(t);
                                const float sn = __builtin_amdgcn_sinf(t), cs = __builtin_amdgcn_cosf(t); const float a = v[n][2 * q], b = v[n][2 * q + 1];
                                v[n][2 * q] = (a * cs - b * sn) * ks; v[n][2 * q + 1] = (a * sn + b * cs) * ks; } }
                    u32x4 w; w.x = cvt_pk_bf16(v[0][0], v[0][1]); w.y = cvt_pk_bf16(v[0][2], v[0][3]); w.z = cvt_pk_bf16(v[1][0], v[1][1]); w.w = cvt_pk_bf16(v[1][2], v[1][3]);
                    *(u32x4*)(rowp + bj * 8) = w; } }
    }
};
struct EpiSwiGLU8 { static constexpr int PERM = 1; static constexpr int NSTORE = 4; unsigned char* H;
    __device__ __forceinline__ void operator()(const f32x4 (&acc)[2][2][4][2], const Unit& u, int wr, int wc, int fr, int fq) const {
        const int row0 = u.pm * BM + wr * 64 + fr + ((fq >> 1) ? 16 : 0), col0 = u.pn * HALF + wc * 32 + 16 * (fq & 1);
#pragma unroll
        for (int ai = 0; ai < 2; ++ai)
#pragma unroll
            for (int mp = 0; mp < 2; ++mp) {
                unsigned d[2][2];
#pragma unroll
                for (int q = 0; q < 2; ++q) { const int m = 2 * mp + q; float hv[8];
#pragma unroll
                    for (int n = 0; n < 2; ++n)
#pragma unroll
                        for (int j = 0; j < 4; ++j) hv[4 * n + j] = fsilu(acc[ai][0][m][n][j] * 0.015625f) * (acc[ai][1][m][n][j] * 0.015625f);
                    int d0 = 0, d1 = 0;
                    d0 = __builtin_amdgcn_cvt_pk_fp8_f32(hv[0], hv[1], d0, false); d0 = __builtin_amdgcn_cvt_pk_fp8_f32(hv[2], hv[3], d0, true);
                    d1 = __builtin_amdgcn_cvt_pk_fp8_f32(hv[4], hv[5], d1, false); d1 = __builtin_amdgcn_cvt_pk_fp8_f32(hv[6], hv[7], d1, true);
                    d[q][0] = (unsigned)d0; d[q][1] = (unsigned)d1; }
                const auto s0 = __builtin_amdgcn_permlane32_swap(d[0][0], d[1][0], false, false);
                const auto s1 = __builtin_amdgcn_permlane32_swap(d[0][1], d[1][1], false, false);
                *(u32x4*)(H + (size_t)(row0 + ai * HALF + mp * 32) * FE + col0) = (u32x4){s0[0], s1[0], s0[1], s1[1]};
            }
    }
};

#define CFG_P2 true, true
#define CFG_P6 true, true
#define CFG_P8 true, true
#define CFG_P9 true, true
template <bool FP8, bool SP2, bool ALIGN_EPI, class Epi, class Sched>
__device__ __forceinline__ void gemm_phase(LAS unsigned char* lds, const char* Abase, const int KB, const Sched& S, const Epi& E, void* dummy) {
    const int tid = threadIdx.x, wid = __builtin_amdgcn_readfirstlane(tid >> 6), lane = tid & 63, wr = wid >> 2, wc = wid & 3, fr = lane & 15, fq = lane >> 4;
    const int nt = KB / (BK * 2);
    int Rp[2]; unsigned cb[2], voffB[2][2];
#pragma unroll
    for (int i = 0; i < 2; ++i) { int R, C; stage_rc(tid * 16 + i * 8192, R, C); Rp[i] = R; cb[i] = (unsigned)C * 2u;
#pragma unroll
        for (int h = 0; h < 2; ++h) { const int Rb = (Epi::PERM == 2) ? (64 * (R >> 5) + 16 * ((R & 15) >> 2) + 8 * h + 4 * ((R >> 4) & 1) + (R & 3)) : (128 * h + (R & ~31) + perm32(R & 31));
            voffB[h][i] = (unsigned)(Rb * KB + C * 2); } }
    const unsigned rowb = (unsigned)KB;
    const size_t kstep = (size_t)(BK * 2);
    const size_t hstep = (size_t)HALF * KB;
    const unsigned ldsw = (unsigned)wid * 1024u;
    const int aoff = FP8 ? lds_byte(wr * 64 + fr, 16 * fq) : lds_byte(wr * 64 + fr, fq * 8), boff = FP8 ? lds_byte(wc * 32 + fr, 16 * fq) : lds_byte(wc * 32 + fr, fq * 8);
    constexpr int KOFF = FP8 ? 16 : 1024;
#define PG8_SA(b, h) (((b) * 2 + (h)) * HTB)
#define PG8_SB(b, h) ((4 + (b) * 2 + (h)) * HTB)
#define PG8_STAGEA(bufoff, kb, av) do { _Pragma("unroll") for (int _i = 0; _i < 2; ++_i) \
        __builtin_amdgcn_global_load_lds((const unsigned*)(Abase + (kb) + (av)[_i]), (LAS unsigned*)(lds + (bufoff) + ldsw + _i * 8192), 16, 0, 0); } while (0)
#define PG8_STAGEB(bufoff, gbase, h) do { _Pragma("unroll") for (int _i = 0; _i < 2; ++_i) \
        __builtin_amdgcn_global_load_lds((const unsigned*)((const char*)(gbase) + voffB[h][_i]), (LAS unsigned*)(lds + (bufoff) + ldsw + _i * 8192), 16, 0, 0); } while (0)
#define PG8_LDA(dst, b, h) do { _Pragma("unroll") for (int m = 0; m < 4; ++m) _Pragma("unroll") for (int k = 0; k < 2; ++k) dst[m][k] = *(const LAS bf16x8*)(lds + PG8_SA(b, h) + aoff + m * 2048 + k * KOFF); } while (0)
#define PG8_LDB(dst, b, h) do { _Pragma("unroll") for (int n = 0; n < 2; ++n) _Pragma("unroll") for (int k = 0; k < 2; ++k) dst[n][k] = *(const LAS bf16x8*)(lds + PG8_SB(b, h) + boff + n * 2048 + k * KOFF); } while (0)
#define PG8_CAT8(x) __builtin_shufflevector(__builtin_bit_cast(i32x4, (x)[0]), __builtin_bit_cast(i32x4, (x)[1]), 0, 1, 2, 3, 4, 5, 6, 7)
#define PG8_MMA(ai, bj, At, Bt) do { __builtin_amdgcn_s_setprio(1); _Pragma("unroll") for (int m = 0; m < 4; ++m) _Pragma("unroll") for (int n = 0; n < 2; ++n) { \
        if constexpr (FP8) { const i32x8 a8_ = PG8_CAT8(Bt[n]), b8_ = PG8_CAT8(At[m]); asm volatile("v_mfma_f32_16x16x128_f8f6f4 %0, %1, %2, %0" : "+v"(acc[ai][bj][m][n]) : "v"(a8_), "v"(b8_)); } \
        else { _Pragma("unroll") for (int k = 0; k < 2; ++k) acc[ai][bj][m][n] = __builtin_amdgcn_mfma_f32_16x16x32_bf16(Bt[n][k], At[m][k], acc[ai][bj][m][n], 0, 0, 0); } } \
        __builtin_amdgcn_s_setprio(0); } while (0)
#define PG8_MMA0(ai, bj, At, Bt) do { __builtin_amdgcn_s_setprio(1); _Pragma("unroll") for (int m = 0; m < 4; ++m) _Pragma("unroll") for (int n = 0; n < 2; ++n) { \
        const i32x8 a8_ = PG8_CAT8(Bt[n]), b8_ = PG8_CAT8(At[m]); asm volatile("v_mfma_f32_16x16x128_f8f6f4 %0, %1, %2, 0" : "=&v"(acc[ai][bj][m][n]) : "v"(a8_), "v"(b8_)); } \
        __builtin_amdgcn_s_setprio(0); } while (0)
#define PG8_WAIT_V(n) asm volatile("s_waitcnt vmcnt(" #n ")" ::: "memory")
#define PG8_WAIT_L(n) asm volatile("s_waitcnt lgkmcnt(" #n ")" ::: "memory")
#define PG8_WAIT_VR do { if constexpr (Epi::NSTORE == 16) PG8_WAIT_V(24); else if constexpr (Epi::NSTORE == 8) PG8_WAIT_V(16); else { static_assert(Epi::NSTORE == 4 || Epi::NSTORE == 8 || Epi::NSTORE == 16, "NSTORE"); PG8_WAIT_V(12); } } while (0)
#define PG8_BAR __builtin_amdgcn_s_barrier()
#define PG8_SCHED __builtin_amdgcn_sched_barrier(0)
    Unit cur, nxt, nn; int ui = 0;
    if (!S.next(0, cur)) return;
    f32x4 acc[2][2][4][2];
    if constexpr (!FP8) {
#pragma unroll
    for (int a = 0; a < 2; ++a)
#pragma unroll
        for (int b = 0; b < 2; ++b)
#pragma unroll
            for (int m = 0; m < 4; ++m)
#pragma unroll
                for (int n = 0; n < 2; ++n) acc[a][b][m][n] = (f32x4){0.f, 0.f, 0.f, 0.f};
    }
    bf16x8 At[4][2], B0[2][2], B1[2][2];
    unsigned ca[2][2], na[2][2]; int ix[2][2];
    S.a_rows(cur, Rp, ix); S.settle();
#pragma unroll
    for (int h = 0; h < 2; ++h)
#pragma unroll
        for (int i = 0; i < 2; ++i) ca[h][i] = (unsigned)ix[h][i] * rowb + cb[i];
    bool has1 = S.next(1, nxt);
    if (has1) { S.a_rows(nxt, Rp, ix); S.settle(); }
    const char* cB = cur.B;
    if constexpr (SP2) {
        PG8_STAGEB(PG8_SB(0, 0), cB, 0); PG8_STAGEB(PG8_SB(0, 1), cB, 1); PG8_STAGEA(PG8_SA(0, 0), 0, ca[0]); PG8_STAGEA(PG8_SA(0, 1), 0, ca[1]);
        if (wr == 1) PG8_BAR;
        PG8_WAIT_V(2); PG8_BAR;
        PG8_STAGEB(PG8_SB(1, 0), cB + kstep, 0); PG8_STAGEA(PG8_SA(1, 0), kstep, ca[0]); PG8_STAGEB(PG8_SB(1, 1), cB + kstep, 1);
        PG8_WAIT_V(6); PG8_BAR;
        if constexpr (FP8) { PG8_STAGEA(PG8_SA(1, 1), kstep, ca[1]);
          u32x4* dz = (u32x4*)dummy + (size_t)(blockIdx.x * 512 + tid) * 16;
#pragma unroll
          for (int q_ = 0; q_ < Epi::NSTORE; ++q_) dz[q_] = (u32x4){0u, 0u, 0u, 0u}; asm volatile("" ::: "memory"); }
    } else {
    PG8_STAGEB(PG8_SB(0, 0), cB, 0); PG8_STAGEA(PG8_SA(0, 0), 0, ca[0]); PG8_STAGEB(PG8_SB(0, 1), cB, 1); PG8_STAGEA(PG8_SA(0, 1), 0, ca[1]);
    if (wr == 1) PG8_BAR;
    PG8_WAIT_V(4); PG8_BAR;
    PG8_STAGEB(PG8_SB(1, 0), cB + kstep, 0); PG8_STAGEA(PG8_SA(1, 0), kstep, ca[0]); PG8_STAGEB(PG8_SB(1, 1), cB + kstep, 1);
    PG8_WAIT_V(6); PG8_BAR;
    }
    for (;;) {
        const bool has_next = has1;
#pragma unroll
        for (int h = 0; h < 2; ++h)
#pragma unroll
            for (int i = 0; i < 2; ++i) na[h][i] = has_next ? ((unsigned)ix[h][i] * rowb + cb[i]) : ca[h][i];
        bool has2 = false;
        if (has_next) { has2 = S.next(ui + 2, nn); if (has2) S.a_rows(nn, Rp, ix); }
        const char* nB = has_next ? nxt.B : cB;
        if constexpr (SP2) {
            if constexpr (FP8) {
                const size_t k1 = kstep, k2 = 2 * kstep, k3 = 3 * kstep;
                const unsigned (&sa0)[2] = ca[0]; const unsigned (&sa1)[2] = ca[1];
                const char* b2 = cB + k2; const char* b3 = b2 + kstep;
            PG8_LDB(B0, 0, 0); PG8_LDB(B1, 0, 1); PG8_SCHED; PG8_LDA(At, 0, 0);
            PG8_WAIT_VR;
            PG8_WAIT_L(0); PG8_BAR; PG8_MMA0(0, 0, At, B0); PG8_MMA0(0, 1, At, B1); PG8_BAR; PG8_SCHED;
            PG8_LDA(At, 0, 1); PG8_STAGEB(PG8_SB(0, 0), b2, 0); PG8_STAGEB(PG8_SB(0, 1), b2, 1); PG8_STAGEA(PG8_SA(0, 0), k2, sa0);
            PG8_WAIT_VR;
            PG8_WAIT_L(0); PG8_BAR; PG8_MMA0(1, 0, At, B0); PG8_MMA0(1, 1, At, B1); PG8_BAR; PG8_SCHED;
            PG8_LDB(B0, 1, 0); PG8_LDB(B1, 1, 1); PG8_SCHED; PG8_LDA(At, 1, 0); PG8_STAGEA(PG8_SA(0, 1), k2, sa1);
            PG8_WAIT_VR; PG8_WAIT_L(0); PG8_BAR; PG8_MMA(0, 0, At, B0); PG8_MMA(0, 1, At, B1); PG8_BAR; PG8_SCHED;
            PG8_LDA(At, 1, 1); PG8_STAGEB(PG8_SB(1, 0), b3, 0); PG8_STAGEB(PG8_SB(1, 1), b3, 1); PG8_STAGEA(PG8_SA(1, 0), k3, sa0);
            PG8_WAIT_V(8); PG8_WAIT_L(0); PG8_BAR; PG8_MMA(1, 0, At, B0); PG8_MMA(1, 1, At, B1); PG8_BAR; PG8_SCHED;
            }
        for (int t = FP8 ? 2 : 0; t < nt; t += 2) {
            const bool last = (t == nt - 2);
            const size_t k1 = (size_t)(t + 1) * kstep;
            const size_t k2 = last ? (size_t)0 : (size_t)(t + 2) * kstep, k3 = k2 + kstep;
            unsigned sa0[2], sa1[2];
#pragma unroll
            for (int i = 0; i < 2; ++i) { sa0[i] = last ? na[0][i] : ca[0][i]; sa1[i] = last ? na[1][i] : ca[1][i]; }
            const char* b2 = last ? nB : cB + k2; const char* b3 = b2 + kstep;
            PG8_LDB(B0, 0, 0); PG8_LDB(B1, 0, 1); PG8_SCHED; PG8_LDA(At, 0, 0); PG8_STAGEA(PG8_SA(1, 1), k1, ca[1]);
            PG8_WAIT_V(8);
            PG8_WAIT_L(0); PG8_BAR; PG8_MMA(0, 0, At, B0); PG8_MMA(0, 1, At, B1); PG8_BAR; PG8_SCHED;
            PG8_LDA(At, 0, 1); PG8_STAGEB(PG8_SB(0, 0), b2, 0); PG8_STAGEB(PG8_SB(0, 1), b2, 1); PG8_STAGEA(PG8_SA(0, 0), k2, sa0);
            PG8_WAIT_V(8);
            PG8_WAIT_L(0); PG8_BAR; PG8_MMA(1, 0, At, B0); PG8_MMA(1, 1, At, B1); PG8_BAR; PG8_SCHED;
            PG8_LDB(B0, 1, 0); PG8_LDB(B1, 1, 1); PG8_SCHED; PG8_LDA(At, 1, 0); PG8_STAGEA(PG8_SA(0, 1), k2, sa1);
            PG8_WAIT_V(8); PG8_WAIT_L(0); PG8_BAR; PG8_MMA(0, 0, At, B0); PG8_MMA(0, 1, At, B1); PG8_BAR; PG8_SCHED;
            PG8_LDA(At, 1, 1); PG8_STAGEB(PG8_SB(1, 0), b3, 0); PG8_STAGEB(PG8_SB(1, 1), b3, 1); PG8_STAGEA(PG8_SA(1, 0), k3, sa0);
            PG8_WAIT_V(8); PG8_WAIT_L(0); PG8_BAR; PG8_MMA(1, 0, At, B0); PG8_MMA(1, 1, At, B1); PG8_BAR; PG8_SCHED;
        }
        } else {
        for (int t = 0; t < nt; t += 2) {
            const bool last = (t == nt - 2);
            const size_t k1 = (size_t)(t + 1) * kstep;
            const size_t k2 = last ? (size_t)0 : (size_t)(t + 2) * kstep, k3 = k2 + kstep;
            unsigned sa0[2], sa1[2];
#pragma unroll
            for (int i = 0; i < 2; ++i) { sa0[i] = last ? na[0][i] : ca[0][i]; sa1[i] = last ? na[1][i] : ca[1][i]; }
            const char* b2 = last ? nB : cB + k2; const char* b3 = b2 + kstep;
            PG8_LDB(B0, 0, 0); PG8_SCHED; PG8_LDA(At, 0, 0); PG8_STAGEA(PG8_SA(1, 1), k1, ca[1]);
            PG8_WAIT_L(8); PG8_BAR; PG8_WAIT_L(0); PG8_MMA(0, 0, At, B0); PG8_BAR; PG8_SCHED;
            PG8_LDB(B1, 0, 1); PG8_STAGEB(PG8_SB(0, 0), b2, 0);
            PG8_BAR; PG8_WAIT_L(0); PG8_MMA(0, 1, At, B1); PG8_BAR;
            PG8_LDA(At, 0, 1); PG8_STAGEA(PG8_SA(0, 0), k2, sa0);
            PG8_BAR; PG8_WAIT_L(0); PG8_MMA(1, 0, At, B0); PG8_BAR; PG8_SCHED;
            PG8_STAGEB(PG8_SB(0, 1), b2, 1);
            PG8_WAIT_V(6); PG8_BAR; PG8_MMA(1, 1, At, B1); PG8_BAR;
            PG8_LDB(B0, 1, 0); PG8_SCHED; PG8_LDA(At, 1, 0); PG8_STAGEA(PG8_SA(0, 1), k2, sa1);
            PG8_WAIT_L(8); PG8_BAR; PG8_WAIT_L(0); PG8_MMA(0, 0, At, B0); PG8_BAR; PG8_SCHED;
            PG8_LDB(B1, 1, 1); PG8_STAGEB(PG8_SB(1, 0), b3, 0);
            PG8_BAR; PG8_WAIT_L(0); PG8_MMA(0, 1, At, B1); PG8_BAR;
            PG8_LDA(At, 1, 1); PG8_STAGEA(PG8_SA(1, 0), k3, sa0);
            PG8_BAR; PG8_WAIT_L(0); PG8_MMA(1, 0, At, B0); PG8_BAR; PG8_SCHED;
            PG8_STAGEB(PG8_SB(1, 1), b3, 1);
            PG8_WAIT_V(6); PG8_BAR; PG8_MMA(1, 1, At, B1); PG8_BAR;
        }
        }
        if constexpr (FP8) PG8_STAGEA(PG8_SA(1, 1), kstep, na[1]);
        if constexpr (ALIGN_EPI) { if (wr == 0) PG8_BAR; }
        if constexpr (FP8) asm volatile("s_nop 15\n\ts_nop 15" ::: "memory");
        E(acc, cur, wr, wc, fr, fq);
        if (!has_next) break;
        if constexpr (!FP8) {
#pragma unroll
        for (int a = 0; a < 2; ++a)
#pragma unroll
            for (int b = 0; b < 2; ++b)
#pragma unroll
                for (int m = 0; m < 4; ++m)
#pragma unroll
                    for (int n = 0; n < 2; ++n) acc[a][b][m][n] = (f32x4){0.f, 0.f, 0.f, 0.f};
        }
        cur = nxt; nxt = nn; has1 = has2; cB = nB; ++ui;
        if constexpr (ALIGN_EPI) { if (wr == 1) PG8_BAR; }
#pragma unroll
        for (int h = 0; h < 2; ++h)
#pragma unroll
            for (int i = 0; i < 2; ++i) ca[h][i] = na[h][i];
    }
    PG8_WAIT_V(0);
    if constexpr (!ALIGN_EPI) { if (wr == 0) PG8_BAR; }
    PG8_BAR;
#undef PG8_SA
#undef PG8_SB
#undef PG8_STAGEA
#undef PG8_STAGEB
#undef PG8_LDA
#undef PG8_LDB
#undef PG8_MMA
#undef PG8_CAT8
#undef PG8_WAIT_V
#undef PG8_WAIT_VR
#undef PG8_MMA0
#undef PG8_WAIT_L
#undef PG8_BAR
#undef PG8_SCHED
}
}

struct TrItem { const float* W; int ldw, k0, n0; bf16_t* WT; int ldk, drow0; bf16_t* WL; float sc8; };
__device__ __forceinline__ void tr_load(const TrItem& t, f32x4 (&v)[8], int lane) {
    const float* src = t.W + (size_t)(t.k0 + (lane >> 3)) * t.ldw + t.n0 + 4 * (lane & 7);
#pragma unroll
    for (int i = 0; i < 8; ++i) v[i] = *(const f32x4*)(src + (size_t)(8 * i) * t.ldw);
}
__device__ __forceinline__ void tr_store(const TrItem& t, const f32x4 (&v)[8], LAS float* scr, int lane) {
    LAS float* wp = scr + (lane >> 3) * 33 + 4 * (lane & 7);
#pragma unroll
    for (int i = 0; i < 8; ++i) { wp[(8 * i) * 33 + 0] = v[i][0]; wp[(8 * i) * 33 + 1] = v[i][1]; wp[(8 * i) * 33 + 2] = v[i][2]; wp[(8 * i) * 33 + 3] = v[i][3]; }
    LDS_WAIT(); asm volatile("" ::: "memory");
    const int c = lane & 7;
#pragma unroll
    for (int j = 0; j < 4; ++j) { const int n = (lane >> 3) + 8 * j; const LAS float* sp = scr + (8 * c) * 33 + n;
        float x[8];
#pragma unroll
        for (int q = 0; q < 8; ++q) x[q] = sp[q * 33];
        if (t.WL) {
            const int e = t.drow0 + n, k = t.k0 + 8 * c; const size_t off = ((size_t)(((k >> 10) * 4 + (e >> 4)) * 32 + ((k >> 5) & 31)) * 64 + ((k >> 3) & 3) * 16 + (e & 15)) * 8;
            unsigned hw[4], lw[4];
#pragma unroll
            for (int q = 0; q < 4; ++q) { hw[q] = cvt_pk_bf16(x[2 * q], x[2 * q + 1]); lw[q] = cvt_pk_bf16(x[2 * q] - bf_lo(hw[q]), x[2 * q + 1] - bf_hi(hw[q])); }
            *(u32x4*)(t.WT + off) = (u32x4){hw[0], hw[1], hw[2], hw[3]}; *(u32x4*)(t.WL + off) = (u32x4){lw[0], lw[1], lw[2], lw[3]}; continue; }
        if (t.sc8 > 0.f) { int d0 = 0, d1 = 0; const float s8 = t.sc8;
            d0 = __builtin_amdgcn_cvt_pk_fp8_f32(x[0] * s8, x[1] * s8, d0, false); d0 = __builtin_amdgcn_cvt_pk_fp8_f32(x[2] * s8, x[3] * s8, d0, true);
            d1 = __builtin_amdgcn_cvt_pk_fp8_f32(x[4] * s8, x[5] * s8, d1, false); d1 = __builtin_amdgcn_cvt_pk_fp8_f32(x[6] * s8, x[7] * s8, d1, true);
            *(u32x2*)((unsigned char*)t.WT + (size_t)(t.drow0 + n) * t.ldk + t.k0 + 8 * c) = (u32x2){(unsigned)d0, (unsigned)d1}; continue; }
        unsigned hw[4];
#pragma unroll
        for (int q = 0; q < 4; ++q) hw[q] = cvt_pk_bf16(x[2 * q], x[2 * q + 1]);
        *(u32x4*)(t.WT + (size_t)(t.drow0 + n) * t.ldk + t.k0 + 8 * c) = (u32x4){hw[0], hw[1], hw[2], hw[3]}; }
    LDS_WAIT(); asm volatile("" ::: "memory");
}
template <class Dec>
__device__ __forceinline__ void tr_run(const Dec& dec, int first, int stride, int end, LAS float* scr, int lane) {
    if (first >= end) return;
    f32x4 va[8], vb[8]; TrItem ia, ib;
    dec(first, ia); tr_load(ia, va, lane);
    for (int it = first; ; it += 2 * stride) {
        const bool hb = it + stride < end;
        if (hb) { dec(it + stride, ib); tr_load(ib, vb, lane); }
        tr_store(ia, va, scr, lane);
        if (!hb) break;
        const bool ha = it + 2 * stride < end;
        if (ha) { dec(it + 2 * stride, ia); tr_load(ia, va, lane); }
        tr_store(ib, vb, scr, lane);
        if (!ha) break;
    }
}

__device__ __forceinline__ void phase_prologue(const Params& p, LAS unsigned char* lds, int bid, int nblk) {
    const int tid = threadIdx.x, lane = tid & 63, wave = __builtin_amdgcn_readfirstlane(tid >> 6);
    unsigned char* ws = p.ws;
    float* mod = (float*)(ws + WS_MOD);
    for (int cg = bid; cg < MODW / 64; cg += nblk) {
        LAS float* sl = (LAS float*)lds;
        { f32x4 cv[8];
#pragma unroll
          for (int j = 0; j < 8; ++j) cv[j] = *((const f32x4*)p.c + tid + NTHREADS * j);
#pragma unroll
          for (int j = 0; j < 8; ++j) *((LAS f32x4*)sl + tid + NTHREADS * j) = (f32x4){fsilu(cv[j][0]), fsilu(cv[j][1]), fsilu(cv[j][2]), fsilu(cv[j][3])}; }
        __syncthreads();
        const int n = cg * 64 + lane, k0 = wave * 256;
        float a[8] = {0.f, 0.f, 0.f, 0.f, 0.f, 0.f, 0.f, 0.f};
        for (int k = k0; k < k0 + 256; k += 32) {
            float w[32];
#pragma unroll
            for (int u = 0; u < 32; ++u) w[u] = p.w_ada[(size_t)(k + u) * MODW + n];
#pragma unroll
            for (int u = 0; u < 32; ++u)
#pragma unroll
                for (int b = 0; b < 8; ++b) a[b] += sl[b * DM + k + u] * w[u];
        }
        LAS float* part = sl + NBATCH * DM;
#pragma unroll
        for (int b = 0; b < 8; ++b) part[(wave * 8 + b) * 64 + lane] = a[b];
        __syncthreads();
        { const int b = tid >> 6; float s = 0.f;
#pragma unroll
            for (int w = 0; w < 8; ++w) s += part[(w * 8 + b) * 64 + lane];
            mod[b * MODW + cg * 64 + lane] = s + p.b_ada[cg * 64 + lane]; }
        __syncthreads();
    }
    { float* gw = (float*)(ws + WS_GATEW); const int per = 8 * DM / nblk;
        if (tid < per) { const int i = bid * per + tid, g = i >> 11, k = i & (DM - 1); gw[i] = p.w_in[(size_t)k * INW + INWM + g]; } }
    LAS float* scr = (LAS float*)(lds + wave * 16384);
    const int gw = bid * NWAVES + wave, NGW = nblk * NWAVES;
    constexpr int I_IN = 32 * 224, I_OUT = 32 * 64, I_SG = 32 * 16, I_SD = 8 * 64, I_R = 32 * 2;
    constexpr int NIT = I_IN + I_OUT + 2 * I_SG + I_SD + I_R;
    bf16_t* WIN = (bf16_t*)(ws + WS_WIN); bf16_t* WOUT = (bf16_t*)(ws + WS_WOUT);
    bf16_t* WGUs = (bf16_t*)(ws + WS_WGU + (size_t)NE * 1024 * DM); bf16_t* WDs = (bf16_t*)(ws + WS_WD + (size_t)NE * DM * FE);
    bf16_t* WRH = (bf16_t*)(ws + WS_WRHI); bf16_t* WRL = (bf16_t*)(ws + WS_WRLO);
    auto dec = [&](int it, TrItem& t) {
        int r = it; t.WL = nullptr;
        if (r < I_IN) { const int kb = r / 224, nb = r % 224; t = TrItem{p.w_in, INW, 64 * kb, 32 * nb, WIN, DM, 32 * nb, nullptr, 0.f}; return; } r -= I_IN;
        if (r < I_OUT) { const int kb = r / 64, nb = r % 64; t = TrItem{p.w_out, DM, 64 * kb, 32 * nb, WOUT, DM, 32 * nb, nullptr, 0.f}; return; } r -= I_OUT;
        if (r < I_SG) { const int kb = r / 16, nb = r % 16, n0 = 32 * nb; t = TrItem{p.ws_gate, FE, 64 * kb, n0, WGUs, DM, 256 * (n0 >> 7) + (n0 & 127), nullptr, 64.f}; return; } r -= I_SG;
        if (r < I_SG) { const int kb = r / 16, nb = r % 16, n0 = 32 * nb; t = TrItem{p.ws_up, FE, 64 * kb, n0, WGUs, DM, 256 * (n0 >> 7) + 128 + (n0 & 127), nullptr, 64.f}; return; } r -= I_SG;
        if (r < I_SD) { const int kb = r / 64, nb = r % 64; t = TrItem{p.ws_down, DM, 64 * kb, 32 * nb, WDs, FE, 32 * nb, nullptr, 64.f}; return; } r -= I_SD;
        { const int kb = r / 2, nb = r % 2; t = TrItem{p.w_router, NE, 64 * kb, 32 * nb, WRH, DM, 32 * nb, WRL, 0.f}; }
    };
    tr_run(dec, gw, NGW, NIT, scr, lane);
}

__device__ __forceinline__ void expert_convert(const Params& p, LAS unsigned char* lds, int qidx = 0) {
    const int lane = threadIdx.x & 63, wave = __builtin_amdgcn_readfirstlane(threadIdx.x >> 6);
    unsigned* q = (unsigned*)(p.ws + WS_CTL) + CW_QUEUE + 64 * qidx;
    LAS float* scr = (LAS float*)(lds + wave * 16384);
    unsigned char* WGU = p.ws + WS_WGU; unsigned char* WD = p.ws + WS_WD;
    constexpr unsigned NITEMS = 64u * 1536u, CH = 16u;
    auto dec = [&](int it, TrItem& t) {
        const int e = it / 1536; int r = it % 1536;
        if (r < 512) { const int kb = r / 16, nb = r % 16, n0 = 32 * nb; t = TrItem{p.w_gate + (size_t)e * DM * FE, FE, 64 * kb, n0, (bf16_t*)(WGU + (size_t)e * 1024 * DM), DM, 256 * (n0 >> 7) + (n0 & 127), nullptr, 64.f}; }
        else if (r < 1024) { r -= 512; const int kb = r / 16, nb = r % 16, n0 = 32 * nb; t = TrItem{p.w_up + (size_t)e * DM * FE, FE, 64 * kb, n0, (bf16_t*)(WGU + (size_t)e * 1024 * DM), DM, 256 * (n0 >> 7) + 128 + (n0 & 127), nullptr, 64.f}; }
        else { r -= 1024; const int kb = r / 64, nb = r % 64; t = TrItem{p.w_down + (size_t)e * FE * DM, DM, 64 * kb, 32 * nb, (bf16_t*)(WD + (size_t)e * DM * FE), FE, 32 * nb, nullptr, 64.f}; }
    };
    for (;;) {
        unsigned base = 0; if (lane == 0) base = __hip_atomic_fetch_add(q, CH, __ATOMIC_RELAXED, __HIP_MEMORY_SCOPE_AGENT);
        base = __builtin_amdgcn_readfirstlane(base);
        if (base >= NITEMS) break;
        tr_run(dec, (int)base, 1, (int)(base + CH), scr, lane);
    }
}

__device__ __forceinline__ void phase_modulate(const Params& p, LAS unsigned char* lds, int bid, int nblk) {
    const int tid = threadIdx.x, lane = tid & 63, wave = __builtin_amdgcn_readfirstlane(tid >> 6);
    const float* mod = (const float*)(p.ws + WS_MOD); const float* gwg = (const float*)(p.ws + WS_GATEW);
    float* gates = (float*)(p.ws + WS_GATES); bf16_t* U1 = (bf16_t*)(p.ws + WS_RA);
    LAS float* sc = (LAS float*)lds; LAS float* sh = sc + DM; LAS float* gw = sh + DM;
    const int rows_per = T / nblk;
    const int row_lo = bid * rows_per, b = row_lo / SEQ;
    { const f32x4 hv = *((const f32x4*)(mod + b * MODW) + tid), sv = *((const f32x4*)(mod + b * MODW + DM) + tid);
      f32x4 gv[8];
#pragma unroll
      for (int j = 0; j < 8; ++j) gv[j] = *((const f32x4*)gwg + tid + NTHREADS * j);
      *((LAS f32x4*)sh + tid) = hv; *((LAS f32x4*)sc + tid) = sv + 1.0f;
#pragma unroll
      for (int j = 0; j < 8; ++j) *((LAS f32x4*)gw + tid + NTHREADS * j) = gv[j]; }
    __syncthreads();
    for (int r0 = row_lo + 2 * wave; r0 < row_lo + rows_per; r0 += 2 * NWAVES) {
        f32x4 xv[2][8];
#pragma unroll
        for (int q = 0; q < 2; ++q)
#pragma unroll
            for (int j = 0; j < 8; ++j) xv[q][j] = __builtin_nontemporal_load((const f32x4*)(p.x + (size_t)(r0 + q) * DM) + lane + 64 * j);
#pragma unroll
        for (int q = 0; q < 2; ++q) {
            const int r = r0 + q;
            u32x2* ur = (u32x2*)(U1 + (size_t)r * DM) + lane;
            float a[8] = {0.f, 0.f, 0.f, 0.f, 0.f, 0.f, 0.f, 0.f};
#pragma unroll
            for (int j = 0; j < 8; ++j) {
                const int col = 4 * lane + 256 * j;
                const f32x4 s = *(const LAS f32x4*)(sc + col), h = *(const LAS f32x4*)(sh + col);
                const f32x4 u = xv[q][j] * s + h;
                ur[64 * j] = (u32x2){cvt_pk_bf16(u[0], u[1]), cvt_pk_bf16(u[2], u[3])};
#pragma unroll
                for (int g = 0; g < 8; ++g) { const f32x4 w = *(const LAS f32x4*)(gw + g * DM + col); a[g] += (u[0] * w[0] + u[1] * w[1]) + (u[2] * w[2] + u[3] * w[3]); }
                asm volatile("" ::: "memory");
            }
#pragma unroll
            for (int g = 0; g < 8; ++g) a[g] = wave_sum(a[g]);
            float o = a[0];
#pragma unroll
            for (int g = 1; g < 8; ++g) o = (lane == g) ? a[g] : o;
            if (lane < 8) gates[(size_t)r * 8 + lane] = o + p.b_gates[lane];
        }
    }
}

__device__ __forceinline__ void retention_naive(const Params& p, LAS unsigned char* lds, int b, int h) {
    const int tid = threadIdx.x, v = tid & 255, dh = tid >> 8;
    const bf16_t* proj = (const bf16_t*)(p.ws + WS_RB); bf16_t* outp = (bf16_t*)(p.ws + WS_RC);
    constexpr int TB = 8;
    LAS float* qs = (LAS float*)lds; LAS float* ks = qs + TB * 256; LAS float* vs = ks + TB * 256; LAS float* red = vs + TB * 256;
    const float g = 1.0f - __builtin_amdgcn_exp2f(-5.0f - (float)h);
    float S[128];
#pragma unroll
    for (int d = 0; d < 128; ++d) S[d] = 0.f;
    for (int t0 = 0; t0 < SEQ; t0 += TB) {
        for (int i = tid; i < TB * 256; i += NTHREADS) { const int s = i >> 8, c = i & 255; const size_t rb = (size_t)(b * SEQ + t0 + s) * INWM;
            qs[i] = bf2f(proj[rb + PC_RQ + h * 256 + c]); ks[i] = bf2f(proj[rb + PC_RK + h * 256 + c]); vs[i] = bf2f(proj[rb + PC_RV + h * 256 + c]); }
        __syncthreads();
        for (int s = 0; s < TB; ++s) {
            const float vv = vs[s * 256 + v]; float o = 0.f;
            const LAS f32x4* q4 = (const LAS f32x4*)(qs + s * 256 + dh * 128); const LAS f32x4* k4 = (const LAS f32x4*)(ks + s * 256 + dh * 128);
#pragma unroll
            for (int d4 = 0; d4 < 32; ++d4) { const f32x4 q = q4[d4], k = k4[d4];
#pragma unroll
                for (int j = 0; j < 4; ++j) { S[4 * d4 + j] = g * S[4 * d4 + j] + k[j] * vv; o += q[j] * S[4 * d4 + j]; } }
            red[(s * 2 + dh) * 256 + v] = o;
        }
        __syncthreads();
        for (int i = tid; i < TB * 256; i += NTHREADS) { const int s = i >> 8, c = i & 255;
            const float o = red[(s * 2) * 256 + c] + red[(s * 2 + 1) * 256 + c];
            outp[(size_t)(b * SEQ + t0 + s) * DM + h * 256 + c] = (bf16_t)(cvt_pk_bf16(o, 0.f) & 0xffffu); }
        __syncthreads();
    }
}
__device__ __forceinline__ void mlstm_naive(const Params& p, LAS unsigned char* lds, int b, int h) {
    const int tid = threadIdx.x, v = tid & 255, dh = tid >> 8;
    const bf16_t* proj = (const bf16_t*)(p.ws + WS_RB); bf16_t* outp = (bf16_t*)(p.ws + WS_RC); const float* gates = (const float*)(p.ws + WS_GATES);
    constexpr int TB = 8;
    LAS float* raw = (LAS float*)lds;
    LAS float* qs = raw + (TB + 3) * 256;
    LAS float* ks = qs + TB * 128;
    LAS float* vs = ks + TB * 128;
    LAS float* red = vs + TB * 256;
    LAS float* rden = red + TB * 2 * 256;
    LAS float* gsc = rden + TB * 2;
    float C[64], n[64];
#pragma unroll
    for (int d = 0; d < 64; ++d) { C[d] = 0.f; n[d] = 0.f; }
    float mrun = 0.f;
    for (int t0 = 0; t0 < SEQ; t0 += TB) {
        for (int i = tid; i < (TB + 3) * 256; i += NTHREADS) { const int s = i >> 8, c = i & 255; const int t = t0 - 3 + s;
            const int col = (c < 128) ? (PC_MQK + h * 128 + c) : (PC_MQK + 512 + h * 128 + (c - 128));
            raw[i] = (t >= 0) ? bf2f(proj[(size_t)(b * SEQ + t) * INWM + col]) : 0.f; }
        for (int i = tid; i < TB * 256; i += NTHREADS) { const int s = i >> 8, c = i & 255; vs[i] = bf2f(proj[(size_t)(b * SEQ + t0 + s) * INWM + PC_MV + h * 256 + c]); }
        __syncthreads();
        for (int i = tid; i < TB * 256; i += NTHREADS) { const int s = i >> 8, c = i & 255;
            const int ch = (c < 128) ? (h * 128 + c) : (512 + h * 128 + (c - 128));
            float a = p.conv_b[ch];
#pragma unroll
            for (int w = 0; w < 4; ++w) a += raw[(s + w) * 256 + c] * p.conv_w[w * 1024 + ch];
            a = fsilu(a);
            if (c < 128) qs[s * 128 + c] = a * 0.08838834764831845f; else ks[s * 128 + (c - 128)] = a; }
        if (tid == 0) { float m = mrun;
            for (int s = 0; s < TB; ++s) { const size_t r = (size_t)(b * SEQ + t0 + s) * 8; const float ip = gates[r + h], fp = gates[r + 4 + h];
                const float lf = fminf(fp, 0.f) - log1pf(__expf(-fabsf(fp)));
                const float mn = fmaxf(lf + m, ip);
                gsc[s * 3 + 0] = __expf(lf + m - mn); gsc[s * 3 + 1] = __expf(ip - mn); gsc[s * 3 + 2] = __expf(-mn); m = mn; }
            gsc[TB * 3] = m; }
        __syncthreads();
        mrun = gsc[TB * 3];
        for (int s = 0; s < TB; ++s) {
            const float fs = gsc[s * 3], is = gsc[s * 3 + 1];
            const float vv = vs[s * 256 + v] * is; float num = 0.f, den = 0.f;
            const LAS f32x4* q4 = (const LAS f32x4*)(qs + s * 128 + dh * 64); const LAS f32x4* k4 = (const LAS f32x4*)(ks + s * 128 + dh * 64);
#pragma unroll
            for (int d4 = 0; d4 < 16; ++d4) { const f32x4 q = q4[d4], k = k4[d4];
#pragma unroll
                for (int j = 0; j < 4; ++j) { C[4 * d4 + j] = fs * C[4 * d4 + j] + k[j] * vv; n[4 * d4 + j] = fs * n[4 * d4 + j] + is * k[j];
                    num += q[j] * C[4 * d4 + j]; den += q[j] * n[4 * d4 + j]; } }
            red[(s * 2 + dh) * 256 + v] = num;
            if (v == 0) rden[s * 2 + dh] = den;
        }
        __syncthreads();
        for (int i = tid; i < TB * 256; i += NTHREADS) { const int s = i >> 8, c = i & 255;
            const float num = red[(s * 2) * 256 + c] + red[(s * 2 + 1) * 256 + c], den = rden[s * 2] + rden[s * 2 + 1];
            const float o = num / fmaxf(fabsf(den), gsc[s * 3 + 2]);
            outp[(size_t)(b * SEQ + t0 + s) * DM + 1024 + h * 256 + c] = (bf16_t)(cvt_pk_bf16(o, 0.f) & 0xffffu); }
        __syncthreads();
    }
}
typedef short s16x4 __attribute__((ext_vector_type(4)));
__device__ __forceinline__ bf16x8 cat4(s16x4 a, s16x4 b) { return __builtin_shufflevector(a, b, 0, 1, 2, 3, 4, 5, 6, 7); }
__device__ __forceinline__ s16x4 tr_read(LAS const unsigned char* q) { return __builtin_amdgcn_ds_read_tr16_b64_v4i16((LAS s16x4*)q); }
__device__ __forceinline__ void unpack8(const u32x4 v, float (&x)[8]) { x[0] = bf_lo(v.x); x[1] = bf_hi(v.x); x[2] = bf_lo(v.y); x[3] = bf_hi(v.y); x[4] = bf_lo(v.z); x[5] = bf_hi(v.z); x[6] = bf_lo(v.w); x[7] = bf_hi(v.w); }
__device__ __forceinline__ u32x4 pack8(const float (&x)[8]) { return (u32x4){cvt_pk_bf16(x[0], x[1]), cvt_pk_bf16(x[2], x[3]), cvt_pk_bf16(x[4], x[5]), cvt_pk_bf16(x[6], x[7])}; }

#define BAR_LDS() do { asm volatile("s_waitcnt lgkmcnt(0)" ::: "memory"); __builtin_amdgcn_s_barrier(); asm volatile("" ::: "memory"); } while (0)
__device__ __forceinline__ void phase_conv(const Params& p, LAS unsigned char* lds, int bid, int nblk) {
    const int tid = threadIdx.x;
    const bf16_t* proj = (const bf16_t*)(p.ws + WS_RB); bf16_t* outc = (bf16_t*)(p.ws + WS_CONV);
    LAS float* cw = (LAS float*)lds;
    { f32x4 wv[3];
#pragma unroll
      for (int j = 0; j < 3; ++j) { const int q = tid + NTHREADS * j; wv[j] = (f32x4){0.f, 0.f, 0.f, 0.f}; if (q < 1280) wv[j] = (q < 1024) ? *((const f32x4*)p.conv_w + q) : *((const f32x4*)p.conv_b + (q - 1024)); }
#pragma unroll
      for (int j = 0; j < 3; ++j) { const int q = tid + NTHREADS * j; if (q < 1280) *((LAS f32x4*)cw + q) = wv[j]; } }
    __syncthreads();
    const int rows_per = T / nblk, row_lo = bid * rows_per;
    for (int it = tid; it < (rows_per / 4) * 128; it += NTHREADS) {
        const int rq = it >> 7, cg = it & 127, c0 = 8 * cg, t0 = row_lo + 4 * rq, s0 = t0 & (SEQ - 1);
        float x[7][8];
#pragma unroll
        for (int u = 0; u < 7; ++u) { u32x4 v = (u32x4){0u, 0u, 0u, 0u}; if (s0 - 3 + u >= 0) v = *(const u32x4*)(proj + (size_t)(t0 - 3 + u) * INWM + PC_MQK + c0); unpack8(v, x[u]); }
        f32x4 wv[5][2];
#pragma unroll
        for (int u = 0; u < 5; ++u) { wv[u][0] = *(const LAS f32x4*)(cw + u * 1024 + c0); wv[u][1] = *(const LAS f32x4*)(cw + u * 1024 + c0 + 4); }
        const float qs = (c0 < 512) ? 0.08838834764831845f : 1.0f;
#pragma unroll
        for (int r = 0; r < 4; ++r) { float a[8];
#pragma unroll
            for (int e = 0; e < 8; ++e) { float acc = wv[4][e >> 2][e & 3];
#pragma unroll
                for (int u = 0; u < 4; ++u) acc += x[r + u][e] * wv[u][e >> 2][e & 3];
                a[e] = fsilu(acc) * qs; }
            *(u32x4*)(outc + (size_t)(t0 + r) * 1024 + c0) = pack8(a); }
    }
}

template <int DK, bool ML>
__device__ __forceinline__ void chain_mfma(const Params& p, LAS unsigned char* lds, int b, int h, int vh, float* gscr) {
    constexpr int PQ = DK * 2 + 16, PV = 272, PP = 144, NDT = DK / 16, NKS = DK / 32, NC = SEQ / 64, NPQ = DK / 64;
    constexpr int O_QS = 0, O_KS = 64 * PQ, O_VS = 128 * PQ, O_VP = O_VS + 64 * PV, O_PS = O_VP + 64 * PV, O_OB = O_PS + 64 * PP, O_VEC = O_OB + 64 * PV;
    static_assert(O_VEC + 8192 <= BARW_OFF, "chain LDS map");
    LAS float* rowterm = (LAS float*)(lds + O_VEC); LAS float* cterm = rowterm + 64; LAS float* winter = cterm + 64; LAS float* enm = winter + 64; LAS float* gkv = enm + 64;
    LAS float* cb63 = gkv + 64;
    LAS float* ccm = cb63 + 64;
    LAS float* cmp_ = ccm + 64;
    LAS float* cmn = cmp_ + 64;
    const int tid = threadIdx.x, lane = tid & 63, w = __builtin_amdgcn_readfirstlane(tid >> 6), r16 = lane & 15, kg = lane >> 4, q4 = r16 >> 2, p4 = lane & 3;
    const bf16_t* proj = (const bf16_t*)(p.ws + WS_RB); bf16_t* outp = (bf16_t*)(p.ws + WS_RC); const float* gates = (const float*)(p.ws + WS_GATES);
    const size_t row0 = (size_t)b * SEQ;
    const bf16_t* qsrc = ML ? ((const bf16_t*)(p.ws + WS_CONV) + h * 128) : (proj + PC_RQ + h * 256);
    const bf16_t* ksrc = ML ? ((const bf16_t*)(p.ws + WS_CONV) + 512 + h * 128) : (proj + PC_RK + h * 256);
    constexpr int QLD = ML ? 1024 : INWM;
    const int vcol = (ML ? PC_MV : PC_RV) + h * 256 + vh * 128, ocol = (ML ? 1024 : 0) + h * 256 + vh * 128;
    const float lg = ML ? 0.f : __log2f(1.0f - __builtin_amdgcn_exp2f(-5.0f - (float)h));
    f32x4 S[NDT], Sn[ML ? NDT : 1];
#pragma unroll
    for (int i = 0; i < NDT; ++i) S[i] = (f32x4){0.f, 0.f, 0.f, 0.f};
#pragma unroll
    for (int i = 0; i < (ML ? NDT : 1); ++i) Sn[i] = (f32x4){0.f, 0.f, 0.f, 0.f};
    float gst = 0.f;
    if (ML) {
        float bcr[8], ctr[8], cmr[8];
#pragma unroll
        for (int q = 0; q < 8; ++q) { const int c = w + 8 * q;
            const float gi_ = gates[(row0 + c * 64 + lane) * 8 + h], gf_ = gates[(row0 + c * 64 + lane) * 8 + 4 + h];
            const float lf = fminf(gf_, 0.f) - __logf(1.0f + __expf(-fabsf(gf_)));
            float bc = lf;
#pragma unroll
            for (int o = 1; o < 64; o <<= 1) { const float t = __shfl_up(bc, o); if (lane >= o) bc += t; }
            const float ct = gi_ - bc; float cm = ct;
#pragma unroll
            for (int o = 1; o < 64; o <<= 1) { const float t = __shfl_up(cm, o); if (lane >= o) cm = fmaxf(cm, t); }
            bcr[q] = bc; ctr[q] = ct; cmr[q] = cm;
            if (lane == 63) { cb63[c] = bc; ccm[c] = cm; } }
        __syncthreads();
        if (tid == 0) { float m = 0.f; for (int c = 0; c < NC; ++c) { cmp_[c] = m; const float mn = cb63[c] + fmaxf(m, ccm[c]); cmn[c] = mn; gscr[5 * SEQ + c] = __expf(cb63[c] + m - mn); m = mn; } }
        __syncthreads();
#pragma unroll
        for (int q = 0; q < 8; ++q) { const int c = w + 8 * q, f = c * 64 + lane; const float mp = cmp_[c], mn = cmn[c], b63 = cb63[c];
            const float m = bcr[q] + fmaxf(mp, cmr[q]);
            gscr[f] = bcr[q] - m; gscr[SEQ + f] = ctr[q]; gscr[2 * SEQ + f] = __expf(bcr[q] + mp - m); gscr[3 * SEQ + f] = __expf(-m); gscr[4 * SEQ + f] = __expf(b63 + ctr[q] - mn); }
    }
    u32x4 pq[NPQ], pk[NPQ], pv[2]; float g_rt = 0.f, g_ct = 0.f, g_wi = 0.f, g_en = 0.f, g_gk = 0.f, g_st = 0.f;
    int tv = tid;
    unsigned oq[NPQ], ov[2];
#pragma unroll
    for (int i = 0; i < NPQ; ++i) { const int id = tid + 512 * i, row = id / (DK / 8), pc = id % (DK / 8); oq[i] = (unsigned)((row * QLD + pc * 8) * 2); }
#pragma unroll
    for (int i = 0; i < 2; ++i) { const int id = tid + 512 * i, row = id >> 4, pc = id & 15; ov[i] = (unsigned)((row * INWM + pc * 8) * 2); }
    auto load_chunk = [&](int c) {
        const char* qb = (const char*)(qsrc + (row0 + (size_t)c * 64) * QLD); const char* kb = (const char*)(ksrc + (row0 + (size_t)c * 64) * QLD);
        const char* vb = (const char*)(proj + (row0 + (size_t)c * 64) * INWM + vcol);
#pragma unroll
        for (int i = 0; i < NPQ; ++i) { pq[i] = *(const u32x4*)(qb + oq[i]); pk[i] = *(const u32x4*)(kb + oq[i]); }
        if (ML) { const int f = c * 64 + lane;
            g_gk = gscr[4 * SEQ + f]; g_st = gscr[5 * SEQ + c];
            if (w == 0) { g_rt = gscr[f]; g_ct = gscr[SEQ + f]; g_wi = gscr[2 * SEQ + f]; g_en = gscr[3 * SEQ + f]; } }
#pragma unroll
        for (int i = 0; i < 2; ++i) pv[i] = *(const u32x4*)(vb + ov[i]);
    };
    auto stage_chunk = [&]() {
#pragma unroll
        for (int i = 0; i < NPQ; ++i) { const int id = tv + 512 * i, row = id / (DK / 8), pc = id % (DK / 8);
            *(LAS u32x4*)(lds + O_QS + row * PQ + pc * 16) = pq[i]; *(LAS u32x4*)(lds + O_KS + row * PQ + pc * 16) = pk[i]; }
        if (ML) { if (w == 0) { rowterm[lane] = g_rt; cterm[lane] = g_ct; winter[lane] = g_wi; enm[lane] = g_en; gkv[lane] = g_gk; }
            gst = g_st; }
#pragma unroll
        for (int i = 0; i < 2; ++i) { const int id = tv + 512 * i, row = id >> 4, pc = id & 15;
            const float sc = ML ? __shfl(g_gk, row) : __builtin_amdgcn_exp2f((float)(63 - row) * lg);
            float x[8]; unpack8(pv[i], x);
#pragma unroll
            for (int e = 0; e < 8; ++e) x[e] *= sc;
            *(LAS u32x4*)(lds + O_VS + row * PV + pc * 16) = pv[i]; *(LAS u32x4*)(lds + O_VP + row * PV + pc * 16) = pack8(x); }
    };
    __syncthreads();
    load_chunk(0);
    stage_chunk();
    __syncthreads();
    for (int c = 0; c < NC; ++c) {
        asm volatile("" : "+v"(tv));
        if (c + 1 < NC) load_chunk(c + 1);
        {
            const int it = w >> 1;
            f32x4 sc[2] = {(f32x4){0.f, 0.f, 0.f, 0.f}, (f32x4){0.f, 0.f, 0.f, 0.f}};
            const LAS unsigned char* qb = lds + O_QS + (16 * it + r16) * PQ + (8 * kg) * 2;
            const LAS unsigned char* kb0 = lds + O_KS + (16 * (2 * (w & 1)) + r16) * PQ + (8 * kg) * 2;
            bf16x8 fa[2], fb0[2], fb1[2];
            fa[0] = *(const LAS bf16x8*)(qb); fb0[0] = *(const LAS bf16x8*)(kb0); fb1[0] = *(const LAS bf16x8*)(kb0 + 16 * PQ);
#pragma unroll
            for (int ks = 0; ks < NKS; ++ks) {
                if (ks + 1 < NKS) { fa[(ks + 1) & 1] = *(const LAS bf16x8*)(qb + 64 * (ks + 1)); fb0[(ks + 1) & 1] = *(const LAS bf16x8*)(kb0 + 64 * (ks + 1)); fb1[(ks + 1) & 1] = *(const LAS bf16x8*)(kb0 + 16 * PQ + 64 * (ks + 1)); }
                sc[0] = __builtin_amdgcn_mfma_f32_16x16x32_bf16(fa[ks & 1], fb0[ks & 1], sc[0], 0, 0, 0);
                sc[1] = __builtin_amdgcn_mfma_f32_16x16x32_bf16(fa[ks & 1], fb1[ks & 1], sc[1], 0, 0, 0);
                __builtin_amdgcn_sched_barrier(0);
            }
#pragma unroll
            for (int jj = 0; jj < 2; ++jj) { const int jt = 2 * (w & 1) + jj, j = 16 * jt + r16; const float ctj = ML ? cterm[j] : 0.f;
                f32x4 rt4 = (f32x4){0.f, 0.f, 0.f, 0.f}; if (ML) rt4 = *(const LAS f32x4*)(rowterm + 16 * it + 4 * kg);
#pragma unroll
                for (int r = 0; r < 4; ++r) { const int i = 16 * it + 4 * kg + r;
                    const float wgt = ML ? __expf(fminf(rt4[r] + ctj, 0.f)) : __builtin_amdgcn_exp2f((float)(i - j) * lg);
                    const float val = (j <= i) ? sc[jj][r] * wgt : 0.f;
                    *(LAS bf16_t*)(lds + O_PS + i * PP + j * 2) = (bf16_t)(cvt_pk_bf16(val, 0.f) & 0xffffu); }
            }
        }
        BAR_LDS();
        {
            bf16x8 bv[2], bvp[2], gkf[2];
#pragma unroll
            for (int ks = 0; ks < 2; ++ks) {
                const LAS unsigned char* a0 = lds + O_VS + (32 * ks + 8 * kg + q4) * PV + (16 * w) * 2 + 8 * p4;
                bv[ks] = cat4(tr_read(a0), tr_read(a0 + 4 * PV));
                const LAS unsigned char* a1 = lds + O_VP + (32 * ks + 8 * kg + q4) * PV + (16 * w) * 2 + 8 * p4;
                bvp[ks] = cat4(tr_read(a1), tr_read(a1 + 4 * PV));
                if (ML) { const f32x4 g0 = *(const LAS f32x4*)(gkv + 32 * ks + 8 * kg), g1 = *(const LAS f32x4*)(gkv + 32 * ks + 8 * kg + 4);
                    gkf[ks] = __builtin_bit_cast(bf16x8, (u32x4){cvt_pk_bf16(g0[0], g0[1]), cvt_pk_bf16(g0[2], g0[3]), cvt_pk_bf16(g1[0], g1[1]), cvt_pk_bf16(g1[2], g1[3])}); }
            }
            const bf16x8 ones = __builtin_bit_cast(bf16x8, (u32x4){0x3f803f80u, 0x3f803f80u, 0x3f803f80u, 0x3f803f80u});
            f32x4 O1[4], O2[4], O1n[ML ? 4 : 1], O2n[ML ? 4 : 1];
            {
                bf16x8 pa[4][2];
#pragma unroll
                for (int it = 0; it < 4; ++it)
#pragma unroll
                    for (int ks = 0; ks < 2; ++ks) pa[it][ks] = *(const LAS bf16x8*)(lds + O_PS + (16 * it + r16) * PP + (32 * ks + 8 * kg) * 2);
                u32x2 ql[2][4], qh[2][4];
                const LAS unsigned char* qa0 = lds + O_QS + r16 * PQ + (4 * kg) * 2;
#pragma unroll
                for (int it = 0; it < 4; ++it) { ql[0][it] = *(const LAS u32x2*)(qa0 + 16 * it * PQ); qh[0][it] = *(const LAS u32x2*)(qa0 + 16 * it * PQ + 32); }
                __builtin_amdgcn_sched_barrier(0);
#pragma unroll
                for (int it = 0; it < 4; ++it) { O1[it] = (f32x4){0.f, 0.f, 0.f, 0.f}; O2[it] = (f32x4){0.f, 0.f, 0.f, 0.f};
                    if (ML) { O1n[it] = (f32x4){0.f, 0.f, 0.f, 0.f}; O2n[it] = (f32x4){0.f, 0.f, 0.f, 0.f}; }
#pragma unroll
                    for (int ks = 0; ks < 2; ++ks) { O1[it] = __builtin_amdgcn_mfma_f32_16x16x32_bf16(pa[it][ks], bv[ks], O1[it], 0, 0, 0);
                        if (ML) O1n[it] = __builtin_amdgcn_mfma_f32_16x16x32_bf16(pa[it][ks], ones, O1n[it], 0, 0, 0); } }
#pragma unroll
                for (int m = 0; m < NKS; ++m) {
                    if (m + 1 < NKS) {
#pragma unroll
                        for (int it = 0; it < 4; ++it) { ql[(m + 1) & 1][it] = *(const LAS u32x2*)(qa0 + 16 * it * PQ + 64 * (m + 1)); qh[(m + 1) & 1][it] = *(const LAS u32x2*)(qa0 + 16 * it * PQ + 64 * (m + 1) + 32); } }
                    const f32x4 s0 = S[2 * m], s1 = S[2 * m + 1];
                    const bf16x8 sb = __builtin_bit_cast(bf16x8, (u32x4){cvt_pk_bf16(s0[0], s0[1]), cvt_pk_bf16(s0[2], s0[3]), cvt_pk_bf16(s1[0], s1[1]), cvt_pk_bf16(s1[2], s1[3])});
                    bf16x8 snb = sb;
                    if (ML) { const f32x4 n0 = Sn[2 * m], n1 = Sn[2 * m + 1];
                        snb = __builtin_bit_cast(bf16x8, (u32x4){cvt_pk_bf16(n0[0], n0[1]), cvt_pk_bf16(n0[2], n0[3]), cvt_pk_bf16(n1[0], n1[1]), cvt_pk_bf16(n1[2], n1[3])}); }
#pragma unroll
                    for (int it = 0; it < 4; ++it) { const bf16x8 a = __builtin_bit_cast(bf16x8, (u32x4){ql[m & 1][it].x, ql[m & 1][it].y, qh[m & 1][it].x, qh[m & 1][it].y});
                        O2[it] = __builtin_amdgcn_mfma_f32_16x16x32_bf16(a, sb, O2[it], 0, 0, 0);
                        if (ML) O2n[it] = __builtin_amdgcn_mfma_f32_16x16x32_bf16(a, snb, O2n[it], 0, 0, 0); }
                    __builtin_amdgcn_sched_barrier(0);
                }
            }
#pragma unroll
            for (int it = 0; it < 4; ++it) {
                const int i0 = 16 * it + 4 * kg; float o[4];
                if (!ML) {
#pragma unroll
                    for (int r = 0; r < 4; ++r) o[r] = O1[it][r] + __builtin_amdgcn_exp2f((float)(i0 + r + 1) * lg) * O2[it][r];
                } else {
                    const f32x4 wi = *(const LAS f32x4*)(winter + i0), en = *(const LAS f32x4*)(enm + i0);
#pragma unroll
                    for (int r = 0; r < 4; ++r) { const float den = O1n[it][r] + wi[r] * O2n[it][r];
                        o[r] = (O1[it][r] + wi[r] * O2[it][r]) / fmaxf(fabsf(den), en[r]); }
                }
#pragma unroll
                for (int r = 0; r < 4; ++r) *(LAS bf16_t*)(lds + O_OB + (i0 + r) * PV + (16 * w + r16) * 2) = (bf16_t)(cvt_pk_bf16(o[r], 0.f) & 0xffffu);
                __builtin_amdgcn_sched_barrier(0);
            }
            const float decay = ML ? gst : __builtin_amdgcn_exp2f(64.0f * lg);
            {
                bf16x8 ka[3][2];
                const LAS unsigned char* kt0 = lds + O_KS + (8 * kg + q4) * PQ + 8 * p4;
#pragma unroll
                for (int d0 = 0; d0 < 2; ++d0)
#pragma unroll
                    for (int ks = 0; ks < 2; ++ks) { const LAS unsigned char* ka_ = kt0 + 32 * ks * PQ + 32 * d0; ka[d0][ks] = cat4(tr_read(ka_), tr_read(ka_ + 4 * PQ)); }
#pragma unroll
                for (int dt = 0; dt < NDT; ++dt) {
                    if (dt + 2 < NDT) {
#pragma unroll
                        for (int ks = 0; ks < 2; ++ks) { const LAS unsigned char* ka_ = kt0 + 32 * ks * PQ + 32 * (dt + 2); ka[(dt + 2) % 3][ks] = cat4(tr_read(ka_), tr_read(ka_ + 4 * PQ)); } }
                    S[dt] = S[dt] * decay;
                    if (ML) Sn[dt] = Sn[dt] * decay;
#pragma unroll
                    for (int ks = 0; ks < 2; ++ks) { S[dt] = __builtin_amdgcn_mfma_f32_16x16x32_bf16(ka[dt % 3][ks], bvp[ks], S[dt], 0, 0, 0);
                        if (ML) Sn[dt] = __builtin_amdgcn_mfma_f32_16x16x32_bf16(ka[dt % 3][ks], gkf[ks], Sn[dt], 0, 0, 0); }
                    __builtin_amdgcn_sched_barrier(0);
                }
            }
        }
        BAR_LDS();
        asm volatile("" : "+v"(tv));
#pragma unroll
        for (int i = 0; i < 2; ++i) { const int id = tv + 512 * i, row = id >> 4, pc = id & 15;
            *(u32x4*)(outp + (row0 + c * 64 + row) * DM + ocol + pc * 8) = *(const LAS u32x4*)(lds + O_OB + row * PV + pc * 16); }
        if (c + 1 < NC) stage_chunk();
        BAR_LDS();
    }
}
#ifndef NAIVE_MIX
#define NAIVE_MIX 0
#endif
__device__ __forceinline__ void phase_mix(const Params& p, LAS unsigned char* lds, int bid, int nblk, int sel = 3, int qidx = 0) {
#if NAIVE_MIX
    if (bid < 32) retention_naive(p, lds, bid >> 2, bid & 3);
    else if (bid < 64) mlstm_naive(p, lds, (bid - 32) >> 2, (bid - 32) & 3);
#else
    if ((bid & 1) == 0 && bid < 256) { const int cid = bid >> 1;
        float* gscr = (float*)(p.ws + WS_BINTOK) + (size_t)cid * 32768;
        if (cid < 64) { if (sel & 1) chain_mfma<256, false>(p, lds, cid >> 3, (cid >> 1) & 3, cid & 1, gscr); }
        else { if (sel & 2) chain_mfma<128, true>(p, lds, (cid - 64) >> 3, ((cid - 64) >> 1) & 3, cid & 1, gscr); } }
#endif
    else if (sel == 3 && qidx == 0) {
        pg8::SchedDense S{T / 256, 4, nblk / 2, bid >> 1, (const char*)(p.ws + WS_WIN), DM * 2, INWM / 256 - 4}; pg8::EpiProj E{(bf16_t*)(p.ws + WS_RB)};
        pg8::gemm_phase<false, CFG_P2>(lds, (const char*)(p.ws + WS_U1B), DM * 2, S, E, p.ws + WS_DUMMY);
    }
    __syncthreads();
    expert_convert(p, lds, qidx);
}

__device__ __forceinline__ void phase_headnorm(const Params& p, LAS unsigned char* lds, int bid, int nblk) {
    const int tid = threadIdx.x, lane = tid & 63, wave = __builtin_amdgcn_readfirstlane(tid >> 6);
    const bf16_t* raw = (const bf16_t*)(p.ws + WS_RC); const bf16_t* proj = (const bf16_t*)(p.ws + WS_RB); bf16_t* mixed = (bf16_t*)(p.ws + WS_RA);
    LAS float* vnw = (LAS float*)lds;
    *((LAS f32x4*)vnw + tid) = (tid < 256) ? *((const f32x4*)p.ret_norm_w + tid) : *((const f32x4*)p.ml_norm_w + (tid - 256));
    __syncthreads();
    const int rpb = T / nblk;
    for (int r0 = bid * rpb + 2 * wave; r0 < (bid + 1) * rpb; r0 += 2 * NWAVES) {
        u32x4 rvq[2][4], gvq[2][4];
#pragma unroll
        for (int q2 = 0; q2 < 2; ++q2)
#pragma unroll
            for (int j = 0; j < 4; ++j) { const int col = 512 * j + 8 * lane; const int gcol = (j < 2) ? (PC_RG + col) : (PC_MO + col - 1024);
                rvq[q2][j] = __builtin_nontemporal_load((const u32x4*)(raw + (size_t)(r0 + q2) * DM + col)); gvq[q2][j] = __builtin_nontemporal_load((const u32x4*)(proj + (size_t)(r0 + q2) * INWM + gcol)); }
#pragma unroll
        for (int q2 = 0; q2 < 2; ++q2)
#pragma unroll
        for (int j = 0; j < 4; ++j) {
            const int r = r0 + q2;
            const int col = 512 * j + 8 * lane;
            const u32x4 rv = rvq[q2][j];
            const u32x4 gv = gvq[q2][j];
            const f32x4 w0 = *(const LAS f32x4*)(vnw + col), w1 = *(const LAS f32x4*)(vnw + col + 4);
            float x[8] = {bf_lo(rv.x), bf_hi(rv.x), bf_lo(rv.y), bf_hi(rv.y), bf_lo(rv.z), bf_hi(rv.z), bf_lo(rv.w), bf_hi(rv.w)};
            float gt[8] = {bf_lo(gv.x), bf_hi(gv.x), bf_lo(gv.y), bf_hi(gv.y), bf_lo(gv.z), bf_hi(gv.z), bf_lo(gv.w), bf_hi(gv.w)};
            float s = 0.f;
#pragma unroll
            for (int q = 0; q < 8; ++q) s += x[q];
            const float mean = half_sum(s) * (1.0f / 256.0f); float s2 = 0.f;
#pragma unroll
            for (int q = 0; q < 8; ++q) { x[q] -= mean; s2 += x[q] * x[q]; }
            const float rstd = 1.0f / sqrtf(half_sum(s2) * (1.0f / 256.0f) + GN_EPS);
            float o[8];
#pragma unroll
            for (int q = 0; q < 8; ++q) { const float wq = (q < 4) ? w0[q & 3] : w1[q & 3]; const float gg = (j < 2) ? fsilu(gt[q]) : fsigmoid(gt[q]); o[q] = x[q] * rstd * wq * gg; }
            *(u32x4*)(mixed + (size_t)r * DM + col) = (u32x4){cvt_pk_bf16(o[0], o[1]), cvt_pk_bf16(o[2], o[3]), cvt_pk_bf16(o[4], o[5]), cvt_pk_bf16(o[6], o[7])};
        }
    }
}

constexpr int PA = 4112;
constexpr int R_AHI = 0, R_ALO = 16 * PA, R_P = 32 * PA, R_LIST = R_P + 8192, R_LCNT = R_LIST + 4096, R_LBASE = R_LCNT + 256;
static_assert(R_LBASE + 256 <= BARW_OFF, "router LDS map");
__device__ __forceinline__ void phase_router(const Params& p, LAS unsigned char* lds, int bid, int nblk, int dry = 0) {
    const int tid = threadIdx.x, lane = tid & 63, wave = __builtin_amdgcn_readfirstlane(tid >> 6);
    unsigned char* ws = p.ws;
    const float* mod = (const float*)(ws + WS_MOD); const bf16_t* mix = (const bf16_t*)(ws + WS_RC);
    unsigned char* U8 = ws + WS_U2; float* wts = (float*)(ws + WS_WTS); unsigned* pos = (unsigned*)(ws + WS_POS);
    int* bin_tok = (int*)(ws + WS_BINTOK); unsigned* count = (unsigned*)(ws + WS_CTL) + CW_CNT + (dry ? 128 : 0);
    const bool do1 = !dry || (dry & 1), do2 = !dry || (dry & 2), do3 = !dry || (dry & 4);
    const bf16_t* WRH = (const bf16_t*)(ws + WS_WRHI); const bf16_t* WRL = (const bf16_t*)(ws + WS_WRLO);
    LAS float* P = (LAS float*)(lds + R_P);
    LAS unsigned* list = (LAS unsigned*)(lds + R_LIST);
    LAS unsigned* lcnt = (LAS unsigned*)(lds + R_LCNT); LAS unsigned* lbase = (LAS unsigned*)(lds + R_LBASE);
    const int tpb = T / nblk;
    const int tok0 = bid * tpb, b = tok0 / SEQ;
    if (tid < 64) lcnt[tid] = 0u;
    LAS float* vg1 = (LAS float*)(lds + R_ALO); LAS float* vlg = vg1 + DM; LAS float* vlb = vlg + DM; LAS float* vsc = vlb + DM; LAS float* vsh = vsc + DM;
    { const f32x4 a0 = *((const f32x4*)(mod + b * MODW + 2 * DM) + tid), a1 = *((const f32x4*)p.ln1_g + tid), a2 = *((const f32x4*)p.ln1_b + tid),
                  a3 = *((const f32x4*)(mod + b * MODW + 4 * DM) + tid), a4 = *((const f32x4*)(mod + b * MODW + 3 * DM) + tid);
      *((LAS f32x4*)vg1 + tid) = a0; *((LAS f32x4*)vlg + tid) = a1; *((LAS f32x4*)vlb + tid) = a2; *((LAS f32x4*)vsc + tid) = a3 + 1.0f; *((LAS f32x4*)vsh + tid) = a4; }
    __syncthreads();
    const float ebias = p.e_bias[lane];
    for (int it = 0; it < tpb / 16; ++it) {
        if (do1)
#pragma unroll
        for (int q = 0; q < 2; ++q) {
            const int tl = 2 * wave + q, t = tok0 + it * 16 + tl;
            const f32x4* xr = (const f32x4*)(p.x + (size_t)t * DM) + lane; const u32x2* mr = (const u32x2*)(mix + (size_t)t * DM) + lane;
            f32x4 v[8]; float s = 0.f;
#pragma unroll
            for (int j = 0; j < 8; ++j) { const f32x4 xv = __builtin_nontemporal_load(xr + 64 * j); const u32x2 mv = __builtin_nontemporal_load(mr + 64 * j); const f32x4 g = *((const LAS f32x4*)vg1 + lane + 64 * j);
                v[j] = xv * DN_ALPHA + g * (f32x4){bf_lo(mv.x), bf_hi(mv.x), bf_lo(mv.y), bf_hi(mv.y)};
                s += (v[j][0] + v[j][1]) + (v[j][2] + v[j][3]); }
            const float mean = wave_sum(s) * (1.0f / DM); float s2 = 0.f;
#pragma unroll
            for (int j = 0; j < 8; ++j) { v[j] = v[j] - mean; s2 += (v[j][0] * v[j][0] + v[j][1] * v[j][1]) + (v[j][2] * v[j][2] + v[j][3] * v[j][3]); }
            const float rstd = 1.0f / sqrtf(wave_sum(s2) * (1.0f / DM) + LN_EPS);
            u32x2* orow = (u32x2*)(ws + WS_X1B + (size_t)t * DM * 2) + lane; unsigned* urow = (unsigned*)(U8 + (size_t)t * DM) + lane;
#pragma unroll
            for (int j = 0; j < 8; ++j) {
                const f32x4 lg = *((const LAS f32x4*)vlg + lane + 64 * j), lb = *((const LAS f32x4*)vlb + lane + 64 * j);
                const f32x4 x1 = v[j] * rstd * lg + lb;
                { const f32x4 xa = x1 * DN_ALPHA; orow[64 * j] = (u32x2){cvt_pk_bf16(xa[0], xa[1]), cvt_pk_bf16(xa[2], xa[3])}; }
                const f32x4 sc = *((const LAS f32x4*)vsc + lane + 64 * j), sh = *((const LAS f32x4*)vsh + lane + 64 * j);
                const f32x4 u = x1 * sc + sh;
                const unsigned h0 = cvt_pk_bf16(u[0], u[1]), h1 = cvt_pk_bf16(u[2], u[3]);
                { int d8 = 0; d8 = __builtin_amdgcn_cvt_pk_fp8_f32(u[0], u[1], d8, false); d8 = __builtin_amdgcn_cvt_pk_fp8_f32(u[2], u[3], d8, true); urow[64 * j] = (unsigned)d8; }
                *(LAS u32x2*)(lds + R_AHI + tl * PA + (4 * lane + 256 * j) * 2) = (u32x2){h0, h1};
            }
        }
        __syncthreads();
        if (do2) {
            const int nt = wave & 3, kh = wave >> 2, fr = lane & 15, fq = lane >> 4;
            f32x4 acc = (f32x4){0.f, 0.f, 0.f, 0.f}, acc2 = acc;
            const bf16_t* bh = WRH + ((size_t)((kh * 4 + nt) * 32) * 64 + lane) * 8; const bf16_t* bl = WRL + ((size_t)((kh * 4 + nt) * 32) * 64 + lane) * 8;
            const LAS unsigned char* ah = lds + R_AHI + fr * PA + (kh * 1024 + 8 * fq) * 2;
#pragma unroll 4
            for (int s = 0; s < 32; ++s) {
                const bf16x8 bhi = *(const bf16x8*)(bh + 512 * s);
                const bf16x8 ahi = *(const LAS bf16x8*)(ah + 64 * s);
                if (s & 1) acc2 = __builtin_amdgcn_mfma_f32_16x16x32_bf16(ahi, bhi, acc2, 0, 0, 0); else acc = __builtin_amdgcn_mfma_f32_16x16x32_bf16(ahi, bhi, acc, 0, 0, 0);
            }
#pragma unroll
            for (int r = 0; r < 4; ++r) P[(kh * 16 + 4 * fq + r) * 64 + 16 * nt + fr] = acc[r] + acc2[r];
        }
        __syncthreads();
        if (do3)
#pragma unroll
        for (int q = 0; q < 2; ++q) {
            const int tl = 2 * wave + q, tloc = it * 16 + tl, t = tok0 + tloc;
            const float logit = P[tl * 64 + lane] + P[(16 + tl) * 64 + lane];
            const float score = 1.0f / (1.0f + __expf(-logit));
            const float bs = score + ebias;
            const unsigned key = (__float_as_uint(bs + 1.0f) & ~63u) | (unsigned)(63 - lane);
            int rk = 0;
#pragma unroll
            for (int x = 1; x < 8; ++x) rk += (__shfl_xor(key, x) > key) ? 1 : 0;
            float gs = (rk < 2) ? bs : 0.f;
            gs += __shfl_xor(gs, 1); gs += __shfl_xor(gs, 2); gs += __shfl_xor(gs, 4);
            const unsigned gkey = (__float_as_uint(gs + 2.0f) & ~7u) | (unsigned)(7 - (lane >> 3));
            int grk = 0;
#pragma unroll
            for (int x = 1; x < 8; ++x) grk += (__shfl_xor(gkey, 8 * x) > gkey) ? 1 : 0;
            const unsigned mkey = (grk < 4) ? key : 0u;
            int erk = 0;
#pragma unroll
            for (int j = 0; j < 64; ++j) erk += ((unsigned)__builtin_amdgcn_readlane((int)mkey, j) > mkey) ? 1 : 0;
            const bool sel = erk < 8;
            const float wsum = wave_sum(sel ? score : 0.f);
            if (sel) {
                const unsigned lr = __hip_atomic_fetch_add(&lcnt[lane], 1u, __ATOMIC_RELAXED, __HIP_MEMORY_SCOPE_WORKGROUP);
                list[tloc * 8 + erk] = ((unsigned)lane << 16) | lr;
                wts[(size_t)t * 8 + erk] = score / wsum * 2.5f;
            }
        }
    }
    __syncthreads();
    if (!do3) return;
    if (tid < 64) lbase[tid] = __hip_atomic_fetch_add(count + tid, lcnt[tid], __ATOMIC_RELAXED, __HIP_MEMORY_SCOPE_AGENT);
    __syncthreads();
    for (int i = tid; i < tpb * 8; i += NTHREADS) { const unsigned v = list[i]; const unsigned e = v >> 16, slot = lbase[e] + (v & 0xffffu); const int t = tok0 + (i >> 3);
        bin_tok[e * 32768 + slot] = t; pos[(size_t)t * 8 + (i & 7)] = (e << 16) | slot; }
}

__device__ __forceinline__ void moe_tables(const Params& p, LAS unsigned char* lds, int& NRT) {
    LAS int* tstart = (LAS int*)(lds + TAB_OFF); LAS int* cstart = tstart + 128; LAS int* cnt = cstart + 128; LAS int* tile_e = cnt + 128;
    const unsigned* count = (const unsigned*)(p.ws + WS_CTL) + CW_CNT;
    const int tid = threadIdx.x;
    if (tid < 64) {
        const int c = (int)count[tid]; const int ntile = (c + 255) >> 8;
        int ps = ntile, pc = c;
#pragma unroll
        for (int o = 1; o < 64; o <<= 1) { const int a = __shfl_up(ps, o), b2 = __shfl_up(pc, o); if (tid >= o) { ps += a; pc += b2; } }
        tstart[tid] = ps - ntile; cstart[tid] = pc - c; cnt[tid] = c;
        if (tid == 63) { tstart[64] = ps; cstart[64] = pc; cnt[64] = T; tstart[65] = ps + T / 256; cstart[65] = pc + T; }
    }
    __syncthreads();
    NRT = tstart[65];
    for (int e = tid >> 3; e < 65; e += NTHREADS / 8) { const int t0 = tstart[e], t1 = tstart[e + 1]; for (int j = t0 + (tid & 7); j < t1; j += 8) tile_e[j] = e; }
    __syncthreads();
}

__device__ __forceinline__ void phase_final(const Params& p, LAS unsigned char* lds, int bid, int nblk, int dry = 0) {
    const int tid = threadIdx.x, lane = tid & 63, wave = __builtin_amdgcn_readfirstlane(tid >> 6);
    int NRT; moe_tables(p, lds, NRT);
    LAS const int* tstart = (LAS const int*)(lds + TAB_OFF);
    const float* mod = (const float*)(p.ws + WS_MOD); const unsigned char* O = p.ws + WS_O;
    const unsigned* pos = (const unsigned*)(p.ws + WS_POS); const float* wts = (const float*)(p.ws + WS_WTS);
    const int tpb = T / nblk;
    for (int t = bid * tpb + wave; t < (bid + 1) * tpb; t += NWAVES) {
        const int b = t / SEQ; const float* g2 = mod + b * MODW + 5 * DM;
        f32x4 a[8];
#pragma unroll
        for (int j = 0; j < 8; ++j) a[j] = (f32x4){0.f, 0.f, 0.f, 0.f};
#pragma unroll
        for (int k = 0; k < 9; ++k) {
            int crow; float w;
            if (k < 8) { const unsigned pv = pos[(size_t)t * 8 + k]; crow = 256 * tstart[pv >> 16] + (int)(pv & 0xffffu); w = wts[(size_t)t * 8 + k] * 0.25f; }
            else { crow = 256 * tstart[64] + t; w = 0.25f; }
            const unsigned* orow8 = (const unsigned*)(O + (size_t)crow * DM) + lane;
#pragma unroll
            for (int j = 0; j < 8; ++j) { const unsigned ov = __builtin_nontemporal_load(orow8 + 64 * j);
                const f32x2 e0 = __builtin_amdgcn_cvt_pk_f32_fp8((int)ov, false), e1 = __builtin_amdgcn_cvt_pk_f32_fp8((int)ov, true);
                a[j] += (f32x4){e0[0], e0[1], e1[0], e1[1]} * w; }
        }
        float* orow = (dry ? (float*)(p.ws + WS_RB) : p.out) + (size_t)t * DM;
        const u32x2* xrow = (const u32x2*)(p.ws + WS_X1B + (size_t)t * DM * 2) + lane;
        f32x4 v[8]; float s = 0.f;
#pragma unroll
        for (int j = 0; j < 8; ++j) { const f32x4 g = *((const f32x4*)g2 + lane + 64 * j); const u32x2 xb = __builtin_nontemporal_load(xrow + 64 * j); const f32x4 d = (f32x4){bf_lo(xb.x), bf_hi(xb.x), bf_lo(xb.y), bf_hi(xb.y)} + g * a[j];
            v[j] = d; s += (d[0] + d[1]) + (d[2] + d[3]); }
        const float mean = wave_sum(s) * (1.0f / DM); float s2 = 0.f;
#pragma unroll
        for (int j = 0; j < 8; ++j) { const f32x4 d = v[j] - mean; v[j] = d; s2 += (d[0] * d[0] + d[1] * d[1]) + (d[2] * d[2] + d[3] * d[3]); }
        const float rstd = 1.0f / sqrtf(wave_sum(s2) * (1.0f / DM) + LN_EPS);
#pragma unroll
        for (int j = 0; j < 8; ++j) { const f32x4 lg = *((const f32x4*)p.ln2_g + lane + 64 * j), lb = *((const f32x4*)p.ln2_b + lane + 64 * j);
            *((f32x4*)orow + lane + 64 * j) = v[j] * rstd * lg + lb; }
    }
}

__global__ void __launch_bounds__(NTHREADS, 2) mega(Params p) {
    extern __shared__ __attribute__((aligned(16))) unsigned char lds_raw[];
    LAS unsigned char* lds = (LAS unsigned char*)lds_raw;
    const int bid = blockIdx.x, nblk = gridDim.x, tid = threadIdx.x;
    volatile LAS unsigned* barw = (volatile LAS unsigned*)(lds + BARW_OFF);
    if (tid < 4) barw[tid] = 0u;
    __syncthreads();
    unsigned* ctl = (unsigned*)(p.ws + WS_CTL);
    const int lo = p.ph_lo, hi = p.ph_hi;
    XcdBarrier bar; bar.bar = ctl + CW_BAR; bar.x = 0; bar.st = barw;
    if (hi - lo > 1) bar = xcd_barrier_post(ctl + CW_BAR, barw);
#ifndef PH_MASK
#define PH_MASK 0x7FF
#endif
#define IN(k) (((PH_MASK >> (k)) & 1) && lo <= (k) && (k) < hi)
#define SEAM(k) do { if (IN(k) && IN((k) + 1)) xcd_barrier(bar); } while (0)
    unsigned char* ws = p.ws;
#ifndef DUP_MASK
#define DUP_MASK 0
#endif
#ifndef DRY_STEPS
#define DRY_STEPS 7
#endif
#ifndef DUP_SEL
#define DUP_SEL 3
#endif
#ifndef DUP_Q
#define DUP_Q 0
#endif
#define DUPK(k) (((DUP_MASK) >> (k)) & 1)
#define P2BODY { pg8::SchedDense S{T / 256, INWM / 256 - 4, nblk, bid, (const char*)(ws + WS_WIN), DM * 2, 0}; pg8::EpiProj E{(bf16_t*)(ws + WS_RB)}; pg8::gemm_phase<false, CFG_P2>(lds, (const char*)(ws + WS_RA), DM * 2, S, E, ws + WS_DUMMY); }
#define P5BODY { pg8::SchedDense S{T / 256, DM / 256, nblk, bid, (const char*)(ws + WS_WOUT), DM * 2, 0}; pg8::EpiPlain E{(bf16_t*)(ws + WS_RC), DM, 1.0f}; pg8::gemm_phase<false, CFG_P6>(lds, (const char*)(ws + WS_RA), DM * 2, S, E, ws + WS_DUMMY); }
#define P7BODY { int NRT; moe_tables(p, lds, NRT); \
        pg8::SchedMoE S{tab, tab + 128, tab + 256, tab + 384, NRT, 4, 0, nblk, bid, (const char*)(ws + WS_WGU), (size_t)1024 * DM, DM, 1, (const int*)(ws + WS_BINTOK)}; \
        pg8::EpiSwiGLU8 E{ws + WS_H}; pg8::gemm_phase<true, CFG_P8>(lds, (const char*)(ws + WS_U2), DM, S, E, ws + WS_DUMMY); }
#define P8BODY(pnoff) { int NRT; moe_tables(p, lds, NRT); \
        pg8::SchedMoE S{tab, tab + 128, tab + 256, tab + 384, NRT, 8, pnoff, nblk, bid, (const char*)(ws + WS_WD), (size_t)DM * FE, FE, 0, nullptr}; \
        pg8::EpiPlain8 E{ws + WS_O, DM, 0.0625f}; pg8::gemm_phase<true, CFG_P9>(lds, (const char*)(ws + WS_H), FE, S, E, ws + WS_DUMMY); }
    LAS const int* tab = (LAS const int*)(lds + TAB_OFF);
    if (IN(0)) { phase_prologue(p, lds, bid, nblk); if (DUPK(0)) { __syncthreads(); phase_prologue(p, lds, bid, nblk); } } SEAM(0);
    if (IN(1)) { phase_modulate(p, lds, bid, nblk); if (DUPK(1)) { __syncthreads(); phase_modulate(p, lds, bid, nblk); } } SEAM(1);
    if (IN(2)) { P2BODY if (DUPK(2)) P2BODY } SEAM(2);
    if (IN(3)) { phase_conv(p, lds, bid, nblk); } SEAM(3);
    if (IN(4)) { phase_mix(p, lds, bid, nblk); if (DUPK(4)) { __syncthreads(); phase_mix(p, lds, bid, nblk, DUP_SEL, DUP_Q); } } SEAM(4);
    if (IN(5)) { phase_headnorm(p, lds, bid, nblk); if (DUPK(5)) phase_headnorm(p, lds, bid, nblk); } SEAM(5);
    if (IN(6)) { P5BODY if (DUPK(6)) P5BODY } SEAM(6);
    if (IN(7)) { if (DUPK(7)) { phase_router(p, lds, bid, nblk, DRY_STEPS); __syncthreads(); } phase_router(p, lds, bid, nblk); } SEAM(7);
    if (IN(8)) { P7BODY if (DUPK(8)) P7BODY } SEAM(8);
    if (IN(9)) { P8BODY(0) if (DUPK(9)) P8BODY(0) } SEAM(9);
    if (IN(10)) { for (int rep_ = DUPK(10) ? 1 : 0; rep_ >= 0; --rep_) { phase_final(p, lds, bid, nblk, rep_); __syncthreads(); } }
#undef IN
#undef SEAM
}

constexpr int NPHASES = 11;
extern "C" void kernel_launch(void* const* d_in, const int* in_sizes, int n_in, void* d_out, int out_size, void* d_ws, size_t ws_size, hipStream_t stream) {
    static int grid = 0;
    if (grid == 0) {
        if (n_in != 23 || in_sizes[0] != T * DM || out_size != T * DM || ws_size < WS_END) { fprintf(stderr, "kernel_launch: unexpected shapes / workspace (%d inputs, ws %zu, need %zu)\n", n_in, ws_size, (size_t)WS_END); grid = -1; return; }
        if (hipFuncSetAttribute((const void*)mega, hipFuncAttributeMaxDynamicSharedMemorySize, LDS_BYTES) != hipSuccess) { fprintf(stderr, "kernel_launch: hipFuncSetAttribute failed\n"); grid = -1; return; }
        int dev = 0, cus = 0, per_cu = 0;
        hipGetDevice(&dev); hipDeviceGetAttribute(&cus, hipDeviceAttributeMultiprocessorCount, dev);
        if (hipOccupancyMaxActiveBlocksPerMultiprocessor(&per_cu, (const void*)mega, NTHREADS, LDS_BYTES) != hipSuccess || per_cu < 1) fprintf(stderr, "kernel_launch: occupancy query says %d\n", per_cu);
        (void)hipGetLastError();
        grid = 256;
        if (cus != 256) fprintf(stderr, "kernel_launch: device has %d CUs; this kernel is built for a resident grid of 256 workgroups\n", cus);
    }
    if (grid < 0) return;
    hipMemsetAsync((char*)d_ws + WS_CTL, 0, CTL_BYTES, stream);
    Params p{};
    const float** f = (const float**)&p;
    for (int i = 0; i < 23; ++i) f[i] = (const float*)d_in[i];
    p.out = (float*)d_out; p.ws = (unsigned char*)d_ws;
#ifndef N_LAUNCHES
#define N_LAUNCHES 1
#endif
    if (N_LAUNCHES == 1) { p.ph_lo = 0; p.ph_hi = NPHASES; hipLaunchKernelGGL(mega, dim3(grid), dim3(NTHREADS), LDS_BYTES, stream, p); }
    else for (int ph = 0; ph < NPHASES; ++ph) {
        p.ph_lo = ph; p.ph_hi = ph + 1;
        hipLaunchKernelGGL(mega, dim3(grid), dim3(NTHREADS), LDS_BYTES, stream, p);
    }
}
```
